# Optimizing an MI355X kernel written in HIP

```python
import jax, jax.numpy as jnp
from jax import lax
import numpy as np

D_MODEL = 1024
BATCH = 8
SEQ = 8192
DEPTH = 4

GRID_W = 64
CTX_LEN = 256
Q_BLOCK = 128
ROPE_THETA = 10000.0
NORM_EPS = 1e-6

GQA_HEADS = 6
GQA_KV_HEADS = 2
GQA_GROUP = GQA_HEADS // GQA_KV_HEADS
HEAD_DIM = 64
MLA_HEADS = 6
MLA_NOPE = 64
MLA_ROPE = 32
MLA_QK = MLA_NOPE + MLA_ROPE
MLA_V = 64
MLA_Q_RANK = 256
MLA_KV_RANK = 128
POOL_WINDOWS = (2, 4, 8, 16)
POOL_GROUPS = len(POOL_WINDOWS)
POOL_GROUP_DIM = 64
POOL_WIDTH = POOL_GROUPS * POOL_GROUP_DIM

MIX_WIDTH = GQA_HEADS * HEAD_DIM + MLA_HEADS * MLA_V + POOL_WIDTH
IN_SIZES = (GQA_HEADS * HEAD_DIM, GQA_KV_HEADS * HEAD_DIM, GQA_KV_HEADS * HEAD_DIM,
            MLA_Q_RANK, MLA_KV_RANK, MLA_ROPE, POOL_WIDTH)
IN_WIDTH = sum(IN_SIZES)
D_FF = 4 * D_MODEL
N_MOD = 6

kernel_name = "hybrid_headgroup_diffusion_prefix_trunk"


def rms_norm(x, g):
    xf = x.astype(jnp.float32)
    y = xf * lax.rsqrt(jnp.mean(xf * xf, axis=-1, keepdims=True) + NORM_EPS)
    return (y * g.astype(jnp.float32)).astype(x.dtype)


def modulate(h, shift, scale):
    return h * (1.0 + scale) + shift


def axial_rope_tables(length, rot_dim):
    rows = length // GRID_W
    row = jnp.repeat(jnp.arange(rows, dtype=jnp.float32), GRID_W)
    col = jnp.tile(jnp.arange(GRID_W, dtype=jnp.float32), rows)
    n = rot_dim // 4
    inv = ROPE_THETA ** (-jnp.arange(n, dtype=jnp.float32) / n)
    ang = jnp.concatenate([row[:, None] * inv, col[:, None] * inv], axis=-1)
    return jnp.cos(ang)[:, None, :], jnp.sin(ang)[:, None, :]


def apply_rope(x, cos, sin):
    half = x.shape[-1] // 2
    xf = x.astype(jnp.float32)
    x1, x2 = xf[..., :half], xf[..., half:]
    return jnp.concatenate([x1 * cos - x2 * sin, x1 * sin + x2 * cos], axis=-1).astype(x.dtype)


def attention(q, k, v, scale):
    b, hk, g, lq, dk = q.shape
    nb = lq // Q_BLOCK
    qb = jnp.moveaxis(q.reshape(b, hk, g, nb, Q_BLOCK, dk), 3, 0)

    def one_block(qi):
        s = jnp.einsum('bhgqd,bhkd->bhgqk', qi, k, preferred_element_type=jnp.float32) * scale
        p = jax.nn.softmax(s, axis=-1)
        return jnp.einsum('bhgqk,bhkd->bhgqd', p.astype(v.dtype), v)

    ob = lax.map(one_block, qb)
    return jnp.moveaxis(ob, 0, 3).reshape(b, hk, g, lq, v.shape[-1])


def merge_heads(o):
    b, hk, g, l, d = o.shape
    return o.transpose(0, 3, 1, 2, 4).reshape(b, l, hk * g * d)


def mixer_inputs(h, w_in, g_q_gqa, g_k_gqa, g_cq, g_ckv, w_uq, w_ukv, g_q_mla, g_k_mla, rope):
    b, l, _ = h.shape
    u = h @ w_in
    offs = np.cumsum(IN_SIZES)[:-1].tolist()
    u_q, u_k, u_v, u_cq, u_ckv, u_kr, pool_in = jnp.split(u, offs, axis=-1)
    qg = rms_norm(u_q.reshape(b, l, GQA_HEADS, HEAD_DIM), g_q_gqa)
    kg = rms_norm(u_k.reshape(b, l, GQA_KV_HEADS, HEAD_DIM), g_k_gqa)
    vg = u_v.reshape(b, l, GQA_KV_HEADS, HEAD_DIM)
    qm = (rms_norm(u_cq, g_cq) @ w_uq).reshape(b, l, MLA_HEADS, MLA_QK)
    kv = (rms_norm(u_ckv, g_ckv) @ w_ukv).reshape(b, l, MLA_HEADS, MLA_NOPE + MLA_V)
    k_rope = jnp.broadcast_to(u_kr[:, :, None, :], (b, l, MLA_HEADS, MLA_ROPE))
    km = jnp.concatenate([kv[..., :MLA_NOPE], k_rope], axis=-1)
    vm = kv[..., MLA_NOPE:]
    qm = rms_norm(qm, g_q_mla)
    km = rms_norm(km, g_k_mla)
    if rope is not None:
        cos_g, sin_g, cos_m, sin_m = rope
        qg = apply_rope(qg, cos_g, sin_g)
        kg = apply_rope(kg, cos_g, sin_g)
        qm = jnp.concatenate([qm[..., :MLA_NOPE], apply_rope(qm[..., MLA_NOPE:], cos_m, sin_m)], axis=-1)
        km = jnp.concatenate([km[..., :MLA_NOPE], apply_rope(km[..., MLA_NOPE:], cos_m, sin_m)], axis=-1)
    qg = qg.reshape(b, l, GQA_KV_HEADS, GQA_GROUP, HEAD_DIM).transpose(0, 2, 3, 1, 4)
    kg = kg.transpose(0, 2, 1, 3)
    vg = vg.transpose(0, 2, 1, 3)
    qm = qm.transpose(0, 2, 1, 3)[:, :, None]
    km = km.transpose(0, 2, 1, 3)
    vm = vm.transpose(0, 2, 1, 3)
    return qg, kg, vg, qm, km, vm, pool_in


def multiscale_pool(u, w_pool, ls_pool):
    b, l, _ = u.shape
    uf = u.astype(jnp.float32)
    cs = jnp.concatenate([jnp.zeros((b, 1, POOL_WIDTH), jnp.float32), jnp.cumsum(uf, axis=1)], axis=1)
    t = jnp.arange(l)
    outs = []
    for gi, w in enumerate(POOL_WINDOWS):
        lo = jnp.maximum(t - w // 2, 0)
        hi = jnp.minimum(t + w // 2, l)
        csg = cs[..., gi * POOL_GROUP_DIM:(gi + 1) * POOL_GROUP_DIM]
        s = jnp.take(csg, hi, axis=1) - jnp.take(csg, lo, axis=1)
        mean = s / (hi - lo).astype(jnp.float32)[None, :, None]
        outs.append(mean - uf[..., gi * POOL_GROUP_DIM:(gi + 1) * POOL_GROUP_DIM])
    y = jnp.stack(outs, axis=2).astype(u.dtype)
    y = jnp.einsum('blgc,gcd->blgd', y, w_pool).reshape(b, l, POOL_WIDTH)
    return y * ls_pool


def token_mix(qg, kg, vg, qm, km, vm, pool_in, w_pool, ls_pool, w_out):
    og = attention(qg, kg, vg, HEAD_DIM ** -0.5)
    om = attention(qm, km, vm, MLA_QK ** -0.5)
    op = multiscale_pool(pool_in, w_pool, ls_pool)
    return jnp.concatenate([merge_heads(og), merge_heads(om), op], axis=-1) @ w_out


def sq_relu_mlp(h, w1, w2):
    return jnp.square(jax.nn.relu(h @ w1)) @ w2


def setup_inputs(seed: int = 0) -> dict:
    key = jax.random.key(seed)
    ks = jax.random.split(key, 24)
    f32 = jnp.float32

    def dense(k, shape, fan_in, s=1.0):
        return jax.random.normal(k, shape, f32) * (s * fan_in ** -0.5)

    def gain(k, shape):
        return 1.0 + 0.1 * jax.random.normal(k, shape, f32)

    return {
        "x": jax.random.normal(ks[0], (BATCH, SEQ, D_MODEL), f32),
        "c": jax.random.normal(ks[1], (BATCH, D_MODEL), f32),
        "ctx": jax.random.normal(ks[2], (BATCH, CTX_LEN, D_MODEL), f32),
        "c_ctx": jax.random.normal(ks[3], (D_MODEL,), f32),
        "w_mod": dense(ks[4], (DEPTH, D_MODEL, N_MOD * D_MODEL), D_MODEL, 0.5),
        "b_mod": 0.02 * jax.random.normal(ks[5], (DEPTH, N_MOD * D_MODEL), f32),
        "g_norm1": gain(ks[6], (DEPTH, D_MODEL)),
        "g_norm2": gain(ks[7], (DEPTH, D_MODEL)),
        "w_in": dense(ks[8], (DEPTH, D_MODEL, IN_WIDTH), D_MODEL),
        "g_q_gqa": gain(ks[9], (DEPTH, HEAD_DIM)),
        "g_k_gqa": gain(ks[10], (DEPTH, HEAD_DIM)),
        "g_cq": gain(ks[11], (DEPTH, MLA_Q_RANK)),
        "g_ckv": gain(ks[12], (DEPTH, MLA_KV_RANK)),
        "w_uq": dense(ks[13], (DEPTH, MLA_Q_RANK, MLA_HEADS * MLA_QK), MLA_Q_RANK),
        "w_ukv": dense(ks[14], (DEPTH, MLA_KV_RANK, MLA_HEADS * (MLA_NOPE + MLA_V)), MLA_KV_RANK),
        "g_q_mla": gain(ks[15], (DEPTH, MLA_QK)),
        "g_k_mla": gain(ks[16], (DEPTH, MLA_QK)),
        "w_pool": dense(ks[17], (DEPTH, POOL_GROUPS, POOL_GROUP_DIM, POOL_GROUP_DIM), POOL_GROUP_DIM),
        "ls_pool": gain(ks[18], (DEPTH, POOL_WIDTH)),
        "w_out": dense(ks[19], (DEPTH, MIX_WIDTH, D_MODEL), MIX_WIDTH),
        "w_mlp1": dense(ks[20], (DEPTH, D_MODEL, D_FF), D_MODEL),
        "w_mlp2": dense(ks[21], (DEPTH, D_FF, D_MODEL), D_FF),
    }


def reference(x, c, ctx, c_ctx, w_mod, b_mod, g_norm1, g_norm2, w_in, g_q_gqa, g_k_gqa, g_cq, g_ckv,
              w_uq, w_ukv, g_q_mla, g_k_mla, w_pool, ls_pool, w_out, w_mlp1, w_mlp2):
    length = x.shape[1]
    cos_g, sin_g = axial_rope_tables(length, HEAD_DIM)
    cos_m, sin_m = axial_rope_tables(length, MLA_ROPE)
    rope = (cos_g.astype(x.dtype), sin_g.astype(x.dtype), cos_m.astype(x.dtype), sin_m.astype(x.dtype))
    x_lat, x_ctx = x, ctx
    for i in range(DEPTH):
        last = i == DEPTH - 1
        mod_lat = (jax.nn.silu(c) @ w_mod[i] + b_mod[i])[:, None, :]
        mod_ctx = (jax.nn.silu(c_ctx) @ w_mod[i] + b_mod[i])[None, None, :]
        sh1, sc1, gt1, sh2, sc2, gt2 = jnp.split(mod_lat, N_MOD, axis=-1)
        csh1, csc1, cgt1, csh2, csc2, cgt2 = jnp.split(mod_ctx, N_MOD, axis=-1)
        layer_w = (w_in[i], g_q_gqa[i], g_k_gqa[i], g_cq[i], g_ckv[i], w_uq[i], w_ukv[i], g_q_mla[i], g_k_mla[i])
        hc = modulate(rms_norm(x_ctx, g_norm1[i]), csh1, csc1)
        qg_c, kg_c, vg_c, qm_c, km_c, vm_c, pool_c = mixer_inputs(hc, *layer_w, None)
        h = modulate(rms_norm(x_lat, g_norm1[i]), sh1, sc1)
        qg, kg, vg, qm, km, vm, pool_l = mixer_inputs(h, *layer_w, rope)
        mix = token_mix(qg, jnp.concatenate([kg_c, kg], axis=2), jnp.concatenate([vg_c, vg], axis=2),
                        qm, jnp.concatenate([km_c, km], axis=2), jnp.concatenate([vm_c, vm], axis=2),
                        pool_l, w_pool[i], ls_pool[i], w_out[i])
        x_lat = x_lat + gt1 * mix
        x_lat = x_lat + gt2 * sq_relu_mlp(modulate(rms_norm(x_lat, g_norm2[i]), sh2, sc2), w_mlp1[i], w_mlp2[i])
        if not last:
            mix_c = token_mix(qg_c, kg_c, vg_c, qm_c, km_c, vm_c, pool_c, w_pool[i], ls_pool[i], w_out[i])
            x_ctx = x_ctx + cgt1 * mix_c
            x_ctx = x_ctx + cgt2 * sq_relu_mlp(modulate(rms_norm(x_ctx, g_norm2[i]), csh2, csc2),
                                               w_mlp1[i], w_mlp2[i])
    return x_lat
```

```cpp
#include <hip/hip_runtime.h>
#include <hip/hip_cooperative_groups.h>
#include <cstdio>
#include <cstdint>
namespace cg = cooperative_groups;
namespace pg8 {
#define PG8_LAS __attribute__((address_space(3)))
typedef unsigned short bf16_t;
typedef short bf16x8 __attribute__((ext_vector_type(8)));
typedef float f32x4 __attribute__((ext_vector_type(4)));
typedef unsigned u32x4 __attribute__((ext_vector_type(4)));
constexpr int BM = 256, BK = 64, HALF = 128, HTB = HALF * BK * 2  , STAGE_BYTES = 8 * HTB, NXCD = 8, WGM = 8;

__host__ __device__ __forceinline__ int lds_byte(int r, int c) { const int st = (r >> 4) * 2 + (c >> 5), rr = r & 15, cc = c & 31, ob = rr * 64 + cc * 2; return st * 1024 + (ob ^ (((ob >> 9) & 1) << 5)); }
__host__ __device__ __forceinline__ void stage_rc(int b, int& R, int& C) { const int st = b / 1024, sb = b % 1024, swz = sb ^ (((sb >> 9) & 1) << 5); R = (st >> 1) * 16 + swz / 64; C = (st & 1) * 32 + (swz % 64) / 2; }
__host__ __device__ __forceinline__ int perm32(int rho) { const int n = rho >> 4, i = rho & 15; return 8 * (i >> 2) + 4 * n + (i & 3); }

struct Unit { int pm, pn, ks; };
struct Gemm { const bf16_t* A; const bf16_t* Bt; int M, N, K, ld; };

struct StaticOrder {
    int nM, nN, nwg, G, c, skipctx;
    __host__ __device__ void init(int M, int N, int G_, int c_, int skipctx_ = 0) { nM = M / BM; if (skipctx_) nM -= nM / 33; nN = N / BM; nwg = nM * nN; G = G_; c = c_; skipctx = skipctx_; }
    __host__ __device__ bool next(int i, Unit& u) const {
        const long L = (long)i * G + c; if (L >= nwg) return false;
        int wgid = (int)L; { const int q = nwg / NXCD, r = nwg % NXCD, xcd = wgid % NXCD, off = wgid / NXCD; wgid = (xcd < r ? xcd * (q + 1) : r * (q + 1) + (xcd - r) * q) + off; }
        const int nig = WGM * nN, gid = wgid / nig, fm = gid * WGM, gsz = (nM - fm) < WGM ? (nM - fm) : WGM;
        u.pm = fm + ((wgid % nig) % gsz); u.pn = (wgid % nig) / gsz; u.ks = 0; if (skipctx) u.pm += u.pm / 32 + 1; return true;
    }
    __device__ __forceinline__ void a_ready(const Unit&) const {}
    __device__ __forceinline__ void done(const Unit&) const {}
};
struct SplitKCtx {
    int G, c;
    __host__ __device__ void init(int G_, int c_) { G = G_; c = c_; }
    __host__ __device__ bool next(int i, Unit& u) const { const int L = i * G + c; if (L >= 256) return false; u.ks = L & 7; u.pn = (L >> 3) & 3; u.pm = (L >> 5) * 33; return true; }
    __device__ __forceinline__ void a_ready(const Unit&) const {}
    __device__ __forceinline__ void done(const Unit&) const {}
};


__device__ __forceinline__ unsigned cvt_pk_bf16(float lo, float hi) { unsigned r; asm volatile("v_cvt_pk_bf16_f32 %0, %1, %2" : "=v"(r) : "v"(lo), "v"(hi)); return r; }
typedef float f32x2 __attribute__((ext_vector_type(2)));
typedef float f32x2_t __attribute__((ext_vector_type(2)));
typedef __bf16 bf16x2_t __attribute__((ext_vector_type(2)));
__device__ __forceinline__ unsigned pk2(float lo, float hi) { f32x2_t v = {lo, hi}; bf16x2_t b = __builtin_convertvector(v, bf16x2_t); return __builtin_bit_cast(unsigned, b); }

template <int ACT, bool SCALE = false> struct EpiBf16 {
    static constexpr bool PERM = true, AFTER_DRAIN = false;
    bf16_t* O; int ldc; int coloff; const float* colscale; int nvalid;
    __device__ __forceinline__ void operator()(const f32x4 (&acc)[2][2][4][2], const Unit& u, int wr, int wc, int fr, int fq) const {
        const int row0 = u.pm * BM + wr * 64 + fr;
        const int col0 = u.pn * BM + wc * 32 + 8 * fq;
        f32x4 cs[2][2];
        if (SCALE) {
#pragma unroll
            for (int bj = 0; bj < 2; ++bj)
#pragma unroll
                for (int n = 0; n < 2; ++n) cs[bj][n] = *(const f32x4*)(colscale + col0 + bj * HALF + 4 * n);
        }
#pragma unroll
        for (int ai = 0; ai < 2; ++ai)
#pragma unroll
            for (int m = 0; m < 4; ++m) { bf16_t* rowp = O + (size_t)(row0 + ai * HALF + m * 16) * ldc + coloff + col0;
#pragma unroll
                for (int bj = 0; bj < 2; ++bj) { f32x4 v0 = acc[ai][bj][m][0], v1 = acc[ai][bj][m][1];
                    if (ACT == 2) {
#pragma unroll
                        for (int e = 0; e < 4; ++e) { float a = fmaxf(v0[e], 0.f), b = fmaxf(v1[e], 0.f); v0[e] = a * a; v1[e] = b * b; } }
                    if (SCALE) { v0 = v0 * cs[bj][0]; v1 = v1 * cs[bj][1]; }
                    u32x4 w; w.x = pk2(v0[0], v0[1]); w.y = pk2(v0[2], v0[3]); w.z = pk2(v1[0], v1[1]); w.w = pk2(v1[2], v1[3]);
                    if (col0 + bj * HALF < nvalid) *(u32x4*)(rowp + bj * HALF) = w; } }
    }
};

struct EpiResid {
    static constexpr bool PERM = true, AFTER_DRAIN = false;
    const float* src_lat; const float* src_ctx; float* dst_lat; float* dst_ctx; const float* gate;
    __device__ __forceinline__ void operator()(const f32x4 (&acc)[2][2][4][2], const Unit& u, int wr, int wc, int fr, int fq) const {
        const int b = u.pm / 33, j = u.pm - b * 33;
        const float* sb; float* db; const float* g;
        if (j == 0) { sb = src_ctx + (size_t)b * 256 * 1024; db = dst_ctx + (size_t)b * 256 * 1024; g = gate + 8 * 6144; }
        else { const size_t o = ((size_t)b * 8192 + (size_t)(j - 1) * 256) * 1024; sb = src_lat + o; db = dst_lat + o; g = gate + b * 6144; }
        const int col0 = u.pn * BM + wc * 32 + 8 * fq;
        f32x4 gv[2][2];
#pragma unroll
        for (int bj = 0; bj < 2; ++bj)
#pragma unroll
            for (int n = 0; n < 2; ++n) gv[bj][n] = *(const f32x4*)(g + col0 + bj * HALF + n * 4);
#pragma unroll
        for (int ai = 0; ai < 2; ++ai)
#pragma unroll
            for (int m = 0; m < 4; ++m) { const size_t off = (size_t)(ai * HALF + wr * 64 + m * 16 + fr) * 1024 + col0;
#pragma unroll
                for (int bj = 0; bj < 2; ++bj)
#pragma unroll
                    for (int n = 0; n < 2; ++n) { const f32x4 bs = *(const f32x4*)(sb + off + bj * HALF + n * 4);
                        *(f32x4*)(db + off + bj * HALF + n * 4) = bs + gv[bj][n] * acc[ai][bj][m][n]; }
                if (m == 3) asm volatile("" ::: "memory"); }
    }
};

struct EpiPartial {
    static constexpr bool PERM = false, AFTER_DRAIN = false;
    float* P;
    __device__ __forceinline__ void operator()(const f32x4 (&acc)[2][2][4][2], const Unit& u, int wr, int wc, int fr, int fq) const {
        float* base = P + ((size_t)u.ks * 2048 + (size_t)(u.pm / 33) * 256) * 1024;
        const int col0 = u.pn * BM + wc * 32 + 4 * fq;
#pragma unroll
        for (int ai = 0; ai < 2; ++ai)
#pragma unroll
            for (int m = 0; m < 4; ++m) { const size_t off = (size_t)(ai * HALF + wr * 64 + m * 16 + fr) * 1024 + col0;
#pragma unroll
                for (int bj = 0; bj < 2; ++bj)
#pragma unroll
                    for (int n = 0; n < 2; ++n) *(f32x4*)(base + off + bj * HALF + n * 16) = acc[ai][bj][m][n]; }
    }
};

template <class Epi, class Sched, bool ALIGN_EPI = false, bool SP2 = false>
__device__ __forceinline__ void gemm_phase(PG8_LAS unsigned char* lds, const Gemm g, const Sched& S, const Epi& E) {
    int tid_ = threadIdx.x; asm volatile("" : "+v"(tid_));
    const int tid = tid_, wid = __builtin_amdgcn_readfirstlane(tid >> 6), lane = tid & 63, wr = wid >> 2, wc = wid & 3, fr = lane & 15, fq = lane >> 4;
    const int K = g.K, nt = K / BK, LD = g.ld ? g.ld : g.K;
    const size_t sstep = (size_t)K * 2;
    unsigned voffA[2], voffB[2];
#pragma unroll
    for (int i = 0; i < 2; ++i) { int R, C; stage_rc(tid * 16 + i * 8192, R, C); const int Rb = Epi::PERM ? ((R & ~31) + perm32(R & 31)) : R;
        voffA[i] = (unsigned)(R * LD + C) * 2u; voffB[i] = (unsigned)(Rb * LD + C) * 2u; }
    const size_t kstep = (size_t)(BK * 2);
    const size_t hstep = (size_t)HALF * LD * 2;
    const size_t tstep = 2 * hstep;
    const unsigned ldsw = (unsigned)wid * 1024u;
    const int aoff = lds_byte(wr * 64 + fr, fq * 8), boff = lds_byte(wc * 32 + fr, fq * 8);
#define PG8_SA(b, h) (((b) * 2 + (h)) * HTB)
#define PG8_SB(b, h) ((4 + (b) * 2 + (h)) * HTB)
#define PG8_STAGE(bufoff, gbase, voff) do { _Pragma("unroll") for (int _i = 0; _i < 2; ++_i) \
        __builtin_amdgcn_global_load_lds((const unsigned*)((const char*)(gbase) + (voff)[_i]), (PG8_LAS unsigned*)(lds + (bufoff) + ldsw + _i * 8192), 16, 0, 0); } while (0)
#define PG8_LDA(dst, b, h) do { _Pragma("unroll") for (int m = 0; m < 4; ++m) _Pragma("unroll") for (int k = 0; k < 2; ++k) dst[m][k] = *(const PG8_LAS bf16x8*)(lds + PG8_SA(b, h) + aoff + m * 2048 + k * 1024); } while (0)
#define PG8_LDB(dst, b, h) do { _Pragma("unroll") for (int n = 0; n < 2; ++n) _Pragma("unroll") for (int k = 0; k < 2; ++k) dst[n][k] = *(const PG8_LAS bf16x8*)(lds + PG8_SB(b, h) + boff + n * 2048 + k * 1024); } while (0)
#define PG8_MMA(ai, bj, At, Bt) do { __builtin_amdgcn_s_setprio(1); _Pragma("unroll") for (int m = 0; m < 4; ++m) _Pragma("unroll") for (int n = 0; n < 2; ++n) _Pragma("unroll") for (int k = 0; k < 2; ++k) \
        acc[ai][bj][m][n] = __builtin_amdgcn_mfma_f32_16x16x32_bf16(Bt[n][k], At[m][k], acc[ai][bj][m][n], 0, 0, 0); __builtin_amdgcn_s_setprio(0); } while (0)
#define PG8_WAIT_V(n) asm volatile("s_waitcnt vmcnt(" #n ")" ::: "memory")
#define PG8_WAIT_L(n) asm volatile("s_waitcnt lgkmcnt(" #n ")" ::: "memory")
#define PG8_BAR __builtin_amdgcn_s_barrier()
#define PG8_SCHED __builtin_amdgcn_sched_barrier(0)
    Unit cur, nxt; int ui = 0;
    if (!S.next(0, cur)) return;
    f32x4 acc[2][2][4][2];
#pragma unroll
    for (int a = 0; a < 2; ++a)
#pragma unroll
        for (int b = 0; b < 2; ++b)
#pragma unroll
            for (int m = 0; m < 4; ++m)
#pragma unroll
                for (int n = 0; n < 2; ++n) acc[a][b][m][n] = (f32x4){0.f, 0.f, 0.f, 0.f};
    bf16x8 At[4][2], B0[2][2], B1[2][2];
    const char* cA = (const char*)g.A + (size_t)cur.pm * tstep + (size_t)cur.ks * sstep; const char* cB = (const char*)g.Bt + (size_t)cur.pn * tstep + (size_t)cur.ks * sstep;
    S.a_ready(cur);
    if constexpr (SP2) {
        PG8_STAGE(PG8_SB(0, 0), cB, voffB); PG8_STAGE(PG8_SB(0, 1), cB + hstep, voffB); PG8_STAGE(PG8_SA(0, 0), cA, voffA); PG8_STAGE(PG8_SA(0, 1), cA + hstep, voffA);
        if (wr == 1) PG8_BAR;
        PG8_WAIT_V(2); PG8_BAR;
        PG8_STAGE(PG8_SB(1, 0), cB + kstep, voffB); PG8_STAGE(PG8_SA(1, 0), cA + kstep, voffA); PG8_STAGE(PG8_SB(1, 1), cB + hstep + kstep, voffB);
        PG8_WAIT_V(6); PG8_BAR;
    } else {
        PG8_STAGE(PG8_SB(0, 0), cB, voffB); PG8_STAGE(PG8_SA(0, 0), cA, voffA); PG8_STAGE(PG8_SB(0, 1), cB + hstep, voffB); PG8_STAGE(PG8_SA(0, 1), cA + hstep, voffA);
        if (wr == 1) PG8_BAR;
        PG8_WAIT_V(4); PG8_BAR;
        PG8_STAGE(PG8_SB(1, 0), cB + kstep, voffB); PG8_STAGE(PG8_SA(1, 0), cA + kstep, voffA); PG8_STAGE(PG8_SB(1, 1), cB + hstep + kstep, voffB);
        PG8_WAIT_V(6); PG8_BAR;
    }
    for (;;) {
        const bool has_next = S.next(ui + 1, nxt);
        const char* nA = has_next ? (const char*)g.A + (size_t)nxt.pm * tstep + (size_t)nxt.ks * sstep : cA; const char* nB = has_next ? (const char*)g.Bt + (size_t)nxt.pn * tstep + (size_t)nxt.ks * sstep : cB;
        for (int t = 0; t < nt; t += 2) {
            const bool last = (t == nt - 2);
            const char* a1 = cA + (size_t)(t + 1) * kstep;
            const char* a2 = last ? nA : cA + (size_t)(t + 2) * kstep; const char* b2 = last ? nB : cB + (size_t)(t + 2) * kstep;
            const char* a3 = a2 + kstep; const char* b3 = b2 + kstep;
            if (last && has_next) S.a_ready(nxt);
            if constexpr (SP2) {
            PG8_LDB(B0, 0, 0); PG8_LDB(B1, 0, 1); PG8_SCHED; PG8_LDA(At, 0, 0); PG8_STAGE(PG8_SA(1, 1), a1 + hstep, voffA);
            PG8_WAIT_V(8); PG8_WAIT_L(0); PG8_BAR; PG8_MMA(0, 0, At, B0); PG8_MMA(0, 1, At, B1); PG8_BAR; PG8_SCHED;
            PG8_LDA(At, 0, 1); PG8_STAGE(PG8_SB(0, 0), b2, voffB); PG8_STAGE(PG8_SB(0, 1), b2 + hstep, voffB); PG8_STAGE(PG8_SA(0, 0), a2, voffA);
            PG8_WAIT_V(8); PG8_WAIT_L(0); PG8_BAR; PG8_MMA(1, 0, At, B0); PG8_MMA(1, 1, At, B1); PG8_BAR; PG8_SCHED;
            PG8_LDB(B0, 1, 0); PG8_LDB(B1, 1, 1); PG8_SCHED; PG8_LDA(At, 1, 0); PG8_STAGE(PG8_SA(0, 1), a2 + hstep, voffA);
            PG8_WAIT_V(8); PG8_WAIT_L(0); PG8_BAR; PG8_MMA(0, 0, At, B0); PG8_MMA(0, 1, At, B1); PG8_BAR; PG8_SCHED;
            PG8_LDA(At, 1, 1); PG8_STAGE(PG8_SB(1, 0), b3, voffB); PG8_STAGE(PG8_SB(1, 1), b3 + hstep, voffB); PG8_STAGE(PG8_SA(1, 0), a3, voffA);
            PG8_WAIT_V(8); PG8_WAIT_L(0); PG8_BAR; PG8_MMA(1, 0, At, B0); PG8_MMA(1, 1, At, B1); PG8_BAR; PG8_SCHED;
            } else {
            PG8_LDB(B0, 0, 0); PG8_SCHED; PG8_LDA(At, 0, 0); PG8_STAGE(PG8_SA(1, 1), a1 + hstep, voffA);
            PG8_WAIT_L(8); PG8_BAR; PG8_WAIT_L(0); PG8_MMA(0, 0, At, B0); PG8_BAR; PG8_SCHED;
            PG8_LDB(B1, 0, 1); PG8_STAGE(PG8_SB(0, 0), b2, voffB);
            PG8_BAR; PG8_WAIT_L(0); PG8_MMA(0, 1, At, B1); PG8_BAR;
            PG8_LDA(At, 0, 1); PG8_STAGE(PG8_SA(0, 0), a2, voffA);
            PG8_BAR; PG8_WAIT_L(0); PG8_MMA(1, 0, At, B0); PG8_BAR; PG8_SCHED;
            PG8_STAGE(PG8_SB(0, 1), b2 + hstep, voffB);
            PG8_WAIT_V(6); PG8_BAR; PG8_MMA(1, 1, At, B1); PG8_BAR;
            PG8_LDB(B0, 1, 0); PG8_SCHED; PG8_LDA(At, 1, 0); PG8_STAGE(PG8_SA(0, 1), a2 + hstep, voffA);
            PG8_WAIT_L(8); PG8_BAR; PG8_WAIT_L(0); PG8_MMA(0, 0, At, B0); PG8_BAR; PG8_SCHED;
            PG8_LDB(B1, 1, 1); PG8_STAGE(PG8_SB(1, 0), b3, voffB);
            PG8_BAR; PG8_WAIT_L(0); PG8_MMA(0, 1, At, B1); PG8_BAR;
            PG8_LDA(At, 1, 1); PG8_STAGE(PG8_SA(1, 0), a3, voffA);
            PG8_BAR; PG8_WAIT_L(0); PG8_MMA(1, 0, At, B0); PG8_BAR; PG8_SCHED;
            PG8_STAGE(PG8_SB(1, 1), b3 + hstep, voffB);
            PG8_WAIT_V(6); PG8_BAR; PG8_MMA(1, 1, At, B1); PG8_BAR;
            }
        }
        if constexpr (ALIGN_EPI) { if (wr == 0) PG8_BAR; }
        if constexpr (!Epi::AFTER_DRAIN) { int t2_ = tid; asm volatile("" : "+v"(t2_));
            E(acc, cur, wr, wc, t2_ & 15, (t2_ & 63) >> 4); S.done(cur); }
        if (!has_next) break;
#pragma unroll
        for (int a = 0; a < 2; ++a)
#pragma unroll
            for (int b = 0; b < 2; ++b)
#pragma unroll
                for (int m = 0; m < 4; ++m)
#pragma unroll
                    for (int n = 0; n < 2; ++n) acc[a][b][m][n] = (f32x4){0.f, 0.f, 0.f, 0.f};
        cur = nxt; cA = nA; cB = nB; ++ui;
        if constexpr (ALIGN_EPI) { if (wr == 1) PG8_BAR; }
    }
    PG8_WAIT_V(0);
    if constexpr (!ALIGN_EPI) { if (wr == 0) PG8_BAR; }
    PG8_BAR;
    if constexpr (Epi::AFTER_DRAIN) { E.fused(acc, cur, wr, wc, fr, fq, lds, wid, lane); S.done(cur); }
#undef PG8_SA
#undef PG8_SB
#undef PG8_STAGE
#undef PG8_LDA
#undef PG8_LDB
#undef PG8_MMA
#undef PG8_WAIT_V
#undef PG8_WAIT_L
#undef PG8_BAR
#undef PG8_SCHED
}
}

#define LAS __attribute__((address_space(3)))
typedef unsigned short bf16_t;
typedef short bf16x8 __attribute__((ext_vector_type(8)));
typedef float f32x4 __attribute__((ext_vector_type(4)));
typedef float f32x16 __attribute__((ext_vector_type(16)));
typedef unsigned u32x4 __attribute__((ext_vector_type(4)));
typedef unsigned u32x2 __attribute__((ext_vector_type(2)));
using pg8::pk2;

constexpr int NB = 8, LSEQ = 8192, LCTX = 256, LTOT = LSEQ + LCTX, NR = NB * LTOT, DM = 1024, DEPTH = 4, DFF = 4096;
constexpr int UW = 1536;
constexpr int NMOD = 6 * DM;
constexpr float EPS = 1e-6f;
constexpr float LOG2E = 1.4426950408889634f;
constexpr float QSCALE_G = 0.125f * LOG2E;
constexpr float QSCALE_M = 0.10206207261596575f * LOG2E;
constexpr int NWAVES = 8, NTHREADS = 512;
constexpr int LDS_BYTES = 131072 + 512;

constexpr size_t MiB = 1u << 20;
constexpr size_t COLB = (size_t)NR * 2;
constexpr size_t OFF_BAR = 880 * 1024;
constexpr size_t OFF_MOD = 0, OFF_MODP = 1 * MiB, OFF_ROPEG = 5 * MiB, OFF_ROPEM = 7 * MiB, OFF_XCTX = 8 * MiB;
constexpr size_t OFF_WIN = 16 * MiB, OFF_WUQ = 28 * MiB, OFF_WUKV = 30 * MiB, OFF_WPOOL = 31 * MiB, OFF_WOUT = 32 * MiB, OFF_W1 = 40 * MiB, OFF_W2 = 72 * MiB;
constexpr size_t OFF_H = 104 * MiB;
constexpr size_t OFF_R = 236 * MiB;
constexpr size_t OFF_U = OFF_R;
constexpr size_t OFF_QMRAW = OFF_U, OFF_KVRAW = OFF_U + 768 * COLB;
constexpr size_t OFF_CQN = OFF_U + 1536 * COLB;
constexpr size_t OFF_CKVN = OFF_CQN + 256 * COLB;
constexpr size_t OFF_Y = OFF_CKVN + 128 * COLB;
constexpr size_t OFF_KR = OFF_Y + 256 * COLB;
constexpr size_t OFF_QG = OFF_KR + 32 * COLB;
constexpr size_t OFF_KG = OFF_QG + 384 * COLB;
constexpr size_t OFF_VTG = OFF_KG + 128 * COLB;
constexpr size_t OFF_QM = OFF_VTG + 128 * COLB;
constexpr size_t OFF_KM = OFF_QM + 576 * COLB;
constexpr size_t OFF_VTM = OFF_KM + 576 * COLB;
constexpr size_t OFF_MIX = OFF_VTM + 384 * COLB;
constexpr size_t OFF_REND = OFF_MIX + 1024 * COLB;
constexpr size_t OFF_A1 = OFF_R;
constexpr size_t WS_NEED = (OFF_REND > OFF_A1 + 4096 * COLB) ? OFF_REND : OFF_A1 + 4096 * COLB;
static_assert(OFF_MODP + 4 * DEPTH * 9 * NMOD * 4 <= OFF_ROPEG, "ws map");
static_assert(OFF_A1 + 4096 * COLB <= OFF_REND + 1, "A1 inside R");

struct Params {
    const float *x, *c, *ctx, *c_ctx, *w_mod, *b_mod, *g_norm1, *g_norm2, *w_in, *g_q_gqa, *g_k_gqa, *g_cq, *g_ckv, *w_uq, *w_ukv, *g_q_mla, *g_k_mla, *w_pool, *ls_pool, *w_out, *w_mlp1, *w_mlp2;
    float* out; unsigned char* ws;
};

__device__ __forceinline__ float bf2f(unsigned short h) { return __uint_as_float((unsigned)h << 16); }
__device__ __forceinline__ void unpack8(const u32x4 w, float (&v)[8]) {
    v[0] = __uint_as_float(w.x << 16); v[1] = __uint_as_float(w.x & 0xffff0000u); v[2] = __uint_as_float(w.y << 16); v[3] = __uint_as_float(w.y & 0xffff0000u);
    v[4] = __uint_as_float(w.z << 16); v[5] = __uint_as_float(w.z & 0xffff0000u); v[6] = __uint_as_float(w.w << 16); v[7] = __uint_as_float(w.w & 0xffff0000u);
}
__device__ __forceinline__ void unpack4(const u32x2 w, float (&v)[4]) {
    v[0] = __uint_as_float(w.x << 16); v[1] = __uint_as_float(w.x & 0xffff0000u); v[2] = __uint_as_float(w.y << 16); v[3] = __uint_as_float(w.y & 0xffff0000u);
}
__device__ __forceinline__ u32x4 pack8(const float (&v)[8]) { u32x4 w; w.x = pk2(v[0], v[1]); w.y = pk2(v[2], v[3]); w.z = pk2(v[4], v[5]); w.w = pk2(v[6], v[7]); return w; }
template <int M> __device__ __forceinline__ float swz_xor(float v) { return __int_as_float(__builtin_amdgcn_ds_swizzle(__float_as_int(v), (M << 10) | 0x1f)); }
__device__ __forceinline__ float xhalf_add(float v) { auto rr = __builtin_amdgcn_permlane32_swap(__float_as_uint(v), __float_as_uint(v), false, false); return __uint_as_float(rr[0]) + __uint_as_float(rr[1]); }
__device__ __forceinline__ float xhalf_max(float v) { auto rr = __builtin_amdgcn_permlane32_swap(__float_as_uint(v), __float_as_uint(v), false, false); return fmaxf(__uint_as_float(rr[0]), __uint_as_float(rr[1])); }
__device__ __forceinline__ float wave_sum(float v) {
    v += swz_xor<1>(v); v += swz_xor<2>(v); v += swz_xor<4>(v); v += swz_xor<8>(v); v += swz_xor<16>(v);
    return xhalf_add(v);
}
__device__ __forceinline__ int perm16(int p) { return (p & ~12) | ((p & 4) << 1) | ((p & 8) >> 1); }

__device__ __forceinline__ void transpose_item(const float* W, int K, int N, bf16_t* WT, LAS float* scr, int item, int lane) {
    const int nblk = N / 32, kb = item / nblk, nb = item % nblk, k0 = 64 * kb, n0 = 32 * nb;
#pragma unroll 8
    for (int i = 0; i < 32; ++i) { const int kk = 2 * i + (lane >> 5); scr[kk * 33 + (lane & 31)] = W[(size_t)(k0 + kk) * N + n0 + (lane & 31)]; }
    asm volatile("s_waitcnt lgkmcnt(0)" ::: "memory");
    const int c = lane & 7;
#pragma unroll
    for (int j = 0; j < 4; ++j) { const int n = (lane >> 3) + 8 * j; const LAS float* s = scr + (8 * c) * 33 + n;
        u32x4 o; o.x = pk2(s[0 * 33], s[1 * 33]); o.y = pk2(s[2 * 33], s[3 * 33]); o.z = pk2(s[4 * 33], s[5 * 33]); o.w = pk2(s[6 * 33], s[7 * 33]);
        *(u32x4*)(WT + (size_t)(n0 + n) * K + k0 + 8 * c) = o; }
    asm volatile("s_waitcnt lgkmcnt(0)" ::: "memory");
}

__device__ __forceinline__ void phase_prologue(const Params& p, LAS unsigned char* lds, int G) {
    const int tid = threadIdx.x, lane = tid & 63, wid = tid >> 6;
    const int gw = blockIdx.x * NWAVES + wid, ngw = G * NWAVES;
    const int gt = blockIdx.x * NTHREADS + tid, ngt = G * NTHREADS;
    unsigned char* ws = p.ws;
    LAS float* sv = (LAS float*)(lds + 71680);
    for (int i = tid; i < 9 * DM; i += NTHREADS) { const float v = (i < 8 * DM) ? p.c[i] : p.c_ctx[i - 8 * DM]; sv[i] = v / (1.f + __expf(-v)); }
    __syncthreads();
    {
        float* modp = (float*)(ws + OFF_MODP);
        for (int it = gt; it < DEPTH * 4 * NMOD; it += ngt) {
            const int n = it % NMOD, ks = (it / NMOD) & 3, l = it / (4 * NMOD);
            const float* w = p.w_mod + ((size_t)l * DM + ks * 256) * NMOD + n;
            float acc[9];
#pragma unroll
            for (int j = 0; j < 9; ++j) acc[j] = 0.f;
#pragma unroll 2
            for (int k = 0; k < 256; k += 4) {
                const float w0 = w[(size_t)k * NMOD], w1 = w[(size_t)(k + 1) * NMOD], w2 = w[(size_t)(k + 2) * NMOD], w3 = w[(size_t)(k + 3) * NMOD];
#pragma unroll
                for (int j = 0; j < 9; ++j) { const f32x4 s = *(const LAS f32x4*)(sv + j * DM + ks * 256 + k); acc[j] += s.x * w0 + s.y * w1 + s.z * w2 + s.w * w3; }
            }
#pragma unroll
            for (int j = 0; j < 9; ++j) modp[(((size_t)ks * DEPTH + l) * 9 + j) * NMOD + n] = acc[j];
        }
    }
    {
        LAS float* scr = (LAS float*)(lds + wid * 8704);
        constexpr int I_IN = 16 * 41, I_UQ = 4 * 18, I_UKV = 2 * 24, I_OUT = 12 * 32  , I_1 = 16 * 128, I_2 = 64 * 32, I_L = I_IN + I_UQ + I_UKV + I_OUT + I_1 + I_2;
        for (int it = gw; it < DEPTH * I_L; it += ngw) {
            const int l = it / I_L; int r = it - l * I_L;
            if (r < I_IN) { transpose_item(p.w_in + (size_t)l * DM * 1312, DM, 1312, (bf16_t*)(ws + OFF_WIN) + (size_t)l * UW * DM, scr, r, lane); continue; } r -= I_IN;
            if (r < I_UQ) { transpose_item(p.w_uq + (size_t)l * 256 * 576, 256, 576, (bf16_t*)(ws + OFF_WUQ) + (size_t)l * 768 * 256, scr, r, lane); continue; } r -= I_UQ;
            if (r < I_UKV) { transpose_item(p.w_ukv + (size_t)l * 128 * 768, 128, 768, (bf16_t*)(ws + OFF_WUKV) + (size_t)l * 768 * 128, scr, r, lane); continue; } r -= I_UKV;
            if (r < I_OUT) { transpose_item(p.w_out + (size_t)l * DM * DM, DM, DM, (bf16_t*)(ws + OFF_WOUT) + (size_t)l * DM * DM, scr, r, lane); continue; } r -= I_OUT;
            if (r < I_1) { transpose_item(p.w_mlp1 + (size_t)l * DM * DFF, DM, DFF, (bf16_t*)(ws + OFF_W1) + (size_t)l * DFF * DM, scr, r, lane); continue; } r -= I_1;
            transpose_item(p.w_mlp2 + (size_t)l * DFF * DM, DFF, DM, (bf16_t*)(ws + OFF_W2) + (size_t)l * DM * DFF, scr, r, lane);
        }
    }
    {
        const u32x4 z = {0u, 0u, 0u, 0u};
        constexpr int ZIN = 224 * DM / 8, ZUQ = 192 * 256 / 8;
        for (int it = gt; it < DEPTH * (ZIN + ZUQ); it += ngt) {
            const int l = it / (ZIN + ZUQ), r = it - l * (ZIN + ZUQ);
            if (r < ZIN) *(u32x4*)((bf16_t*)(ws + OFF_WIN) + (size_t)l * UW * DM + (size_t)1312 * DM + (size_t)r * 8) = z;
            else *(u32x4*)((bf16_t*)(ws + OFF_WUQ) + (size_t)l * 768 * 256 + (size_t)576 * 256 + (size_t)(r - ZIN) * 8) = z;
        }
    }
    {
        for (int it = gt; it < DEPTH * DM * 256; it += ngt) {
            const int kk = it & 255, n = (it >> 8) & (DM - 1), l = it >> 18;
            const int g = kk >> 6, cc = kk & 63;
            const float* wp = p.w_pool + (((size_t)l * 4 + g) * 64 + cc) * 64;
            const float* ls = p.ls_pool + l * 256 + g * 64;
            const float* wo = p.w_out + ((size_t)l * DM + 768 + g * 64) * DM + n;
            float acc = 0.f;
#pragma unroll 16
            for (int d = 0; d < 64; ++d) acc += (wp[d] * ls[d]) * wo[(size_t)d * DM];
            ((bf16_t*)(ws + OFF_WOUT))[((size_t)l * DM + n) * DM + 768 + kk] = (bf16_t)(pk2(acc, 0.f) & 0xffffu);
        }
    }
    {
        float* tg = (float*)(ws + OFF_ROPEG); float* tm = (float*)(ws + OFF_ROPEM);
        for (int it = gt; it < LSEQ * 48; it += ngt) {
            const int t = it / 48, j = it - t * 48;
            const int row = t >> 6, col = t & 63;
            double pos, e;
            if (j < 32) { pos = (j < 16) ? (double)row : (double)col; e = (double)(j & 15) / 16.0; }
            else { const int jj = j - 32; pos = (jj < 8) ? (double)row : (double)col; e = (double)(jj & 7) / 8.0; }
            const float inv = (float)exp2(-e * 13.287712379549449);
            const float angf = (float)pos * inv;
            const double a = (double)angf;
            const double kk = rint(a * 0.15915494309189535);
            const float rr = (float)(a - kk * 6.283185307179586);
            const float cs = __cosf(rr), sn = __sinf(rr);
            if (j < 32) { tg[t * 64 + j] = cs; tg[t * 64 + 32 + j] = sn; }
            else { tm[t * 32 + (j - 32)] = cs; tm[t * 32 + 16 + (j - 32)] = sn; }
        }
    }
}

__device__ __forceinline__ void phase_modfinal(const Params& p, int G) {
    const int gt = blockIdx.x * NTHREADS + threadIdx.x, ngt = G * NTHREADS;
    const float* modp = (const float*)(p.ws + OFF_MODP); float* mod = (float*)(p.ws + OFF_MOD);
    constexpr int TOT = DEPTH * 9 * NMOD;
    for (int it = gt; it < TOT; it += ngt) {
        const int n = it % NMOD, l = it / (9 * NMOD);
        mod[it] = p.b_mod[l * NMOD + n] + ((modp[it] + modp[TOT + it]) + (modp[2 * TOT + it] + modp[3 * TOT + it]));
    }
}

__device__ __forceinline__ f32x4 ldg4(const float* p) { return *(const f32x4*)p; }
__device__ __forceinline__ void phase_norm(const float* lat, const float* ctx, const float* g, const float* mod, int shoff, int scoff, bf16_t* H, int gw, int ngw, int lane) {
    constexpr int R = 3;
    f32x4 gg[4];
#pragma unroll
    for (int j = 0; j < 4; ++j) gg[j] = ldg4(g + 4 * (lane + 64 * j));
    for (int gi = gw; gi < NR / R; gi += ngw) {
        const int r0 = gi * R;
        f32x4 v[R][4]; const float* md[R];
#pragma unroll
        for (int q = 0; q < R; ++q) {
            const int r = r0 + q, b = r / LTOT, pp = r - b * LTOT;
            const float* xr;
            if (pp < LCTX) { xr = ctx + ((size_t)b * LCTX + pp) * DM; md[q] = mod + 8 * NMOD; }
            else { xr = lat + ((size_t)b * LSEQ + (pp - LCTX)) * DM; md[q] = mod + b * NMOD; }
#pragma unroll
            for (int j = 0; j < 4; ++j) v[q][j] = ((const f32x4*)xr)[lane + 64 * j];
        }
        f32x4 sh[R][4], sc[R][4];
#pragma unroll
        for (int q = 0; q < R; ++q)
#pragma unroll
            for (int j = 0; j < 4; ++j) { const int col = 4 * (lane + 64 * j); sh[q][j] = ldg4(md[q] + shoff + col); sc[q][j] = ldg4(md[q] + scoff + col); }
#pragma unroll
        for (int q = 0; q < R; ++q) {
            float ss = 0.f;
#pragma unroll
            for (int j = 0; j < 4; ++j) ss += (v[q][j].x * v[q][j].x + v[q][j].y * v[q][j].y) + (v[q][j].z * v[q][j].z + v[q][j].w * v[q][j].w);
            ss = wave_sum(ss);
            const float rstd = 1.0f / sqrtf(ss * (1.0f / DM) + EPS);
#pragma unroll
            for (int j = 0; j < 4; ++j) {
                const int col = 4 * (lane + 64 * j);
                const f32x4 y = (v[q][j] * rstd) * gg[j] * (sc[q][j] + 1.0f) + sh[q][j];
                u32x2 w; w.x = pk2(y.x, y.y); w.y = pk2(y.z, y.w);
                *(u32x2*)(H + (size_t)(r0 + q) * DM + col) = w;
            }
        }
    }
}

__device__ __forceinline__ void phase_prep1(const Params& p, int layer, int gw, int ngw, int lane) {
    constexpr int R = 2;
    unsigned char* ws = p.ws;
    const bf16_t* U = (const bf16_t*)(ws + OFF_U);
    bf16_t* Qg = (bf16_t*)(ws + OFF_QG); bf16_t* Kg = (bf16_t*)(ws + OFF_KG); bf16_t* Vg = (bf16_t*)(ws + OFF_VTG);
    bf16_t* CQn = (bf16_t*)(ws + OFF_CQN); bf16_t* CKVn = (bf16_t*)(ws + OFF_CKVN); bf16_t* KR = (bf16_t*)(ws + OFF_KR); bf16_t* Y = (bf16_t*)(ws + OFF_MIX) + 768;
    const float* tabg = (const float*)(ws + OFF_ROPEG);
    const int ch = (lane + 16) & 63;
    float g1[8], g2[8];
    {
        const float* gv = ((lane < 48) ? p.g_q_gqa : p.g_k_gqa) + layer * 64 + 8 * (lane & 7);
        const f32x4 a = ldg4(gv), b = ldg4(gv + 4);
        g1[0] = a.x; g1[1] = a.y; g1[2] = a.z; g1[3] = a.w; g1[4] = b.x; g1[5] = b.y; g1[6] = b.z; g1[7] = b.w;
        const float* gw2 = (ch < 16) ? (p.g_cq + layer * 256) : (ch < 48) ? (p.g_cq + layer * 256 + 8 * (ch - 16)) : (p.g_ckv + layer * 128 + 8 * (ch - 48));
        const f32x4 c = ldg4(gw2), d = ldg4(gw2 + 4);
        g2[0] = c.x; g2[1] = c.y; g2[2] = c.z; g2[3] = c.w; g2[4] = d.x; g2[5] = d.y; g2[6] = d.z; g2[7] = d.w;
    }
    const int gi_ = lane >> 4, half = 1 << gi_;
    for (int gidx = gw; gidx < NR / R; gidx += ngw) {
        const int r0 = gidx * R;
        u32x4 w1[R], w2[R], wk[R]; u32x2 wp[R], nb[R][16]; f32x4 rc[R][2], rs[R][2];
        bool isctx[R]; int lo[R], hi[R];
#pragma unroll
        for (int q = 0; q < R; ++q) {
            const int r = r0 + q, b = r / LTOT, pp = r - b * LTOT;
            isctx[q] = pp < LCTX; const int t = isctx[q] ? 0 : pp - LCTX;
            const bf16_t* u = U + (size_t)r * UW;
            w1[q] = *(const u32x4*)(u + 8 * lane);
            w2[q] = *(const u32x4*)(u + 512 + 8 * ch);
            wk[q] = *(const u32x4*)(u + 1024 + 8 * (lane & 3));
            wp[q] = *(const u32x2*)(u + 1056 + 4 * lane);
            const int tt = isctx[q] ? pp : t, len = isctx[q] ? LCTX : LSEQ;
            lo[q] = max(tt - half, 0); hi[q] = min(tt + half, len);
#pragma unroll
            for (int jj = 0; jj < 16; ++jj) {
                const int j = tt + jj - 8;
                nb[q][jj] = (u32x2){0u, 0u};
                if (j >= lo[q] && j < hi[q]) nb[q][jj] = *(const u32x2*)(u + (ptrdiff_t)(jj - 8) * UW + 1056 + 4 * lane);
            }
            const float* tb = tabg + (size_t)t * 64 + 8 * (lane & 3);
            rc[q][0] = ldg4(tb); rc[q][1] = ldg4(tb + 4); rs[q][0] = ldg4(tb + 32); rs[q][1] = ldg4(tb + 36);
        }
#pragma unroll
        for (int q = 0; q < R; ++q) {
            const int r = r0 + q;
            {
                float v[8]; unpack8(w1[q], v);
                float ss = 0.f;
#pragma unroll
                for (int i = 0; i < 8; ++i) ss += v[i] * v[i];
                ss += swz_xor<1>(ss); ss += swz_xor<2>(ss); ss += swz_xor<4>(ss);
                const float rstd = 1.0f / sqrtf(ss * (1.0f / 64.0f) + EPS);
#pragma unroll
                for (int i = 0; i < 8; ++i) v[i] = v[i] * rstd * g1[i];
                const float cs[8] = {rc[q][0].x, rc[q][0].y, rc[q][0].z, rc[q][0].w, rc[q][1].x, rc[q][1].y, rc[q][1].z, rc[q][1].w};
                const float sn[8] = {rs[q][0].x, rs[q][0].y, rs[q][0].z, rs[q][0].w, rs[q][1].x, rs[q][1].y, rs[q][1].z, rs[q][1].w};
                float o[8];
#pragma unroll
                for (int i = 0; i < 8; ++i) {
                    const float pr = swz_xor<4>(v[i]);
                    if (isctx[q]) o[i] = v[i];
                    else o[i] = ((lane & 7) < 4) ? (v[i] * cs[i] - pr * sn[i]) : (pr * sn[i] + v[i] * cs[i]);
                }
                if (lane < 48) {
#pragma unroll
                    for (int i = 0; i < 8; ++i) o[i] *= QSCALE_G;
                    *(u32x4*)(Qg + (size_t)r * 384 + 8 * lane) = pack8(o);
                } else *(u32x4*)(Kg + (size_t)r * 128 + 8 * (lane - 48)) = pack8(o);
            }
            {
                float v[8]; unpack8(w2[q], v);
                float ss = 0.f;
#pragma unroll
                for (int i = 0; i < 8; ++i) ss += v[i] * v[i];
                ss += swz_xor<1>(ss); ss += swz_xor<2>(ss); ss += swz_xor<4>(ss); ss += swz_xor<8>(ss);
                const float ss2 = ss + swz_xor<16>(ss);
                if (ch < 16) {
                    *(u32x4*)(Vg + (size_t)r * 128 + 8 * ch) = w2[q];
                } else if (ch < 48) {
                    const float rstd = 1.0f / sqrtf(ss2 * (1.0f / 256.0f) + EPS);
#pragma unroll
                    for (int i = 0; i < 8; ++i) v[i] = v[i] * rstd * g2[i];
                    *(u32x4*)(CQn + (size_t)r * 256 + 8 * (ch - 16)) = pack8(v);
                } else {
                    const float rstd = 1.0f / sqrtf(ss * (1.0f / 128.0f) + EPS);
#pragma unroll
                    for (int i = 0; i < 8; ++i) v[i] = v[i] * rstd * g2[i];
                    *(u32x4*)(CKVn + (size_t)r * 128 + 8 * (ch - 48)) = pack8(v);
                }
            }
            if (lane < 4) *(u32x4*)(KR + (size_t)r * 32 + 8 * lane) = wk[q];
            {
                float v[4]; unpack4(wp[q], v);
                float s[4] = {0.f, 0.f, 0.f, 0.f};
#pragma unroll
                for (int jj = 0; jj < 16; ++jj) { float nv[4]; unpack4(nb[q][jj], nv);
#pragma unroll
                    for (int i = 0; i < 4; ++i) s[i] += nv[i]; }
                const float inv = 1.0f / (float)(hi[q] - lo[q]);
                u32x2 w; w.x = pk2(s[0] * inv - v[0], s[1] * inv - v[1]); w.y = pk2(s[2] * inv - v[2], s[3] * inv - v[3]);
                *(u32x2*)(Y + (size_t)r * 1024 + 4 * lane) = w;
            }
        }
    }
}

__device__ __forceinline__ void phase_prep2(const Params& p, int layer, int gw, int ngw, int lane) {
    constexpr int R = 3;
    unsigned char* ws = p.ws;
    const bf16_t* QMraw = (const bf16_t*)(ws + OFF_QMRAW); const bf16_t* KVraw = (const bf16_t*)(ws + OFF_KVRAW); const bf16_t* KR = (const bf16_t*)(ws + OFF_KR);
    bf16_t* Qm = (bf16_t*)(ws + OFF_QM); bf16_t* Km = (bf16_t*)(ws + OFF_KM);
    const float* tabm = (const float*)(ws + OFF_ROPEM);
    const int h = (lane < 48) ? (lane >> 3) : 5, j8 = lane & 7; const bool act = lane < 48;
    float gn[2][8], gr[2][4];
#pragma unroll
    for (int which = 0; which < 2; ++which) {
        const float* gv = (which == 0 ? p.g_q_mla : p.g_k_mla) + layer * 96;
        const f32x4 a = ldg4(gv + 8 * j8), b = ldg4(gv + 8 * j8 + 4), c = ldg4(gv + 64 + 4 * j8);
        gn[which][0] = a.x; gn[which][1] = a.y; gn[which][2] = a.z; gn[which][3] = a.w; gn[which][4] = b.x; gn[which][5] = b.y; gn[which][6] = b.z; gn[which][7] = b.w;
        gr[which][0] = c.x; gr[which][1] = c.y; gr[which][2] = c.z; gr[which][3] = c.w;
    }
    for (int gidx = gw; gidx < NR / R; gidx += ngw) {
        const int r0 = gidx * R;
        u32x4 wn[R][2]; u32x2 wr[R][2]; f32x4 rc[R], rs[R]; bool isctx[R];
#pragma unroll
        for (int q = 0; q < R; ++q) {
            const int r = r0 + q, b = r / LTOT, pp = r - b * LTOT;
            isctx[q] = pp < LCTX; const int t = isctx[q] ? 0 : pp - LCTX;
            wn[q][0] = *(const u32x4*)(QMraw + (size_t)r * 768 + h * 96 + 8 * j8); wr[q][0] = *(const u32x2*)(QMraw + (size_t)r * 768 + h * 96 + 64 + 4 * j8);
            wn[q][1] = *(const u32x4*)(KVraw + (size_t)r * 768 + h * 128 + 8 * j8); wr[q][1] = *(const u32x2*)(KR + (size_t)r * 32 + 4 * j8);
            const float* tb = tabm + (size_t)t * 32 + 4 * (j8 & 3);
            rc[q] = ldg4(tb); rs[q] = ldg4(tb + 16);
        }
#pragma unroll
        for (int q = 0; q < R; ++q) {
            const int r = r0 + q;
            const float cs[4] = {rc[q].x, rc[q].y, rc[q].z, rc[q].w}, sn[4] = {rs[q].x, rs[q].y, rs[q].z, rs[q].w};
#pragma unroll
            for (int which = 0; which < 2; ++which) {
                float vn[8], vr[4]; unpack8(wn[q][which], vn); unpack4(wr[q][which], vr);
                float ss = 0.f;
#pragma unroll
                for (int i = 0; i < 8; ++i) ss += vn[i] * vn[i];
#pragma unroll
                for (int i = 0; i < 4; ++i) ss += vr[i] * vr[i];
                ss += swz_xor<1>(ss); ss += swz_xor<2>(ss); ss += swz_xor<4>(ss);
                const float rstd = 1.0f / sqrtf(ss * (1.0f / 96.0f) + EPS);
                const float qs = which == 0 ? QSCALE_M : 1.0f;
#pragma unroll
                for (int i = 0; i < 8; ++i) vn[i] = vn[i] * rstd * gn[which][i] * qs;
#pragma unroll
                for (int i = 0; i < 4; ++i) vr[i] = vr[i] * rstd * gr[which][i];
                float o[4];
#pragma unroll
                for (int i = 0; i < 4; ++i) {
                    const float pr = swz_xor<4>(vr[i]);
                    if (isctx[q]) o[i] = vr[i];
                    else o[i] = (j8 < 4) ? (vr[i] * cs[i] - pr * sn[i]) : (pr * sn[i] + vr[i] * cs[i]);
                    o[i] *= qs;
                }
                if (act) {
                    bf16_t* dst = (which == 0 ? Qm : Km) + (size_t)r * 576 + h * 96;
                    *(u32x4*)(dst + 8 * j8) = pack8(vn);
                    u32x2 w; w.x = pk2(o[0], o[1]); w.y = pk2(o[2], o[3]);
                    *(u32x2*)(dst + 64 + 4 * j8) = w;
                }
            }
        }
    }
}

typedef short s16x4 __attribute__((ext_vector_type(4)));
__device__ __forceinline__ s16x4 vtr(LAS unsigned char* p) { return __builtin_bit_cast(s16x4, __builtin_amdgcn_ds_read_tr16_b64_v4i16((LAS s16x4*)p)); }
constexpr float ATT_BMAX = 56.0f;
template <int DK> struct AttnCtx {
    static constexpr int KSTR = DK * 2 + 16, VSTR = 192, NDS = DK / 16, KCH = DK / 8, KBUF = 64 * 208, VBUF = 64 * 192;
};
template <int DK, int PAR, bool HASNEXT, bool LDK, bool LDV, bool STK>
__device__ __forceinline__ void attn_step(LAS unsigned char* lds, f32x16& C0, f32x16& C1, f32x16& N0, f32x16& N1, f32x16& o0, f32x16& o1, float& l,
                                          const bf16x8 (&qf)[DK / 16], const bf16_t* kg0, const bf16_t* kg1, const bf16_t* vg, size_t kstep, size_t vstep, int t,
                                          bool has1, int kl0, int kl1, int vl, int aoffk, int aoffv,
                                          u32x4& ldk0, u32x4& ldk1, u32x4& ldv, const u32x4& stk0, const u32x4& stk1, const u32x4& stv) {
    using A = AttnCtx<DK>;
    LAS unsigned char* Kb = lds + ((PAR ^ 1) * A::KBUF);
    LAS unsigned char* Vb = lds + 2 * A::KBUF + PAR * A::VBUF;
    __builtin_amdgcn_s_setprio(1);
    if (LDK) { ldk0 = *(const u32x4*)(kg0 + (size_t)(t + 3) * kstep); if (has1) ldk1 = *(const u32x4*)(kg1 + (size_t)(t + 3) * kstep); }
    if (LDV) ldv = *(const u32x4*)(vg + (size_t)(t + 2) * vstep);
    bf16x8 kf[A::NDS][2];
    if (HASNEXT) {
#pragma unroll
        for (int ds = 0; ds < A::NDS; ++ds) {
            kf[ds][0] = *(const LAS bf16x8*)(Kb + aoffk + ds * 32);
            kf[ds][1] = *(const LAS bf16x8*)(Kb + aoffk + 32 * A::KSTR + ds * 32);
        }
    }
    s16x4 vlo[4][2], vhi[4][2];
#pragma unroll
    for (int j = 0; j < 2; ++j) {
        vlo[j][0] = vtr(Vb + aoffv + j * 16 * A::VSTR); vhi[j][0] = vtr(Vb + aoffv + (j * 16 + 8) * A::VSTR);
        vlo[j][1] = vtr(Vb + aoffv + j * 16 * A::VSTR + 64); vhi[j][1] = vtr(Vb + aoffv + (j * 16 + 8) * A::VSTR + 64);
    }
    if (HASNEXT) {
        f32x16 z;
#pragma unroll
        for (int i = 0; i < 16; ++i) z[i] = 0.f;
#pragma unroll
        for (int ds = 0; ds < A::NDS; ++ds) {
            N0 = __builtin_amdgcn_mfma_f32_32x32x16_bf16(kf[ds][0], qf[ds], ds == 0 ? z : N0, 0, 0, 0);
            N1 = __builtin_amdgcn_mfma_f32_32x32x16_bf16(kf[ds][1], qf[ds], ds == 0 ? z : N1, 0, 0, 0);
        }
    }
#pragma unroll
    for (int i = 0; i < 16; ++i) { l += C0[i]; l += C1[i]; }
    bf16x8 pb[4];
    { u32x4 w;
      w.x = pk2(C0[0], C0[1]); w.y = pk2(C0[2], C0[3]); w.z = pk2(C0[4], C0[5]); w.w = pk2(C0[6], C0[7]); pb[0] = __builtin_bit_cast(bf16x8, w);
      w.x = pk2(C0[8], C0[9]); w.y = pk2(C0[10], C0[11]); w.z = pk2(C0[12], C0[13]); w.w = pk2(C0[14], C0[15]); pb[1] = __builtin_bit_cast(bf16x8, w);
      w.x = pk2(C1[0], C1[1]); w.y = pk2(C1[2], C1[3]); w.z = pk2(C1[4], C1[5]); w.w = pk2(C1[6], C1[7]); pb[2] = __builtin_bit_cast(bf16x8, w);
      w.x = pk2(C1[8], C1[9]); w.y = pk2(C1[10], C1[11]); w.z = pk2(C1[12], C1[13]); w.w = pk2(C1[14], C1[15]); pb[3] = __builtin_bit_cast(bf16x8, w); }
    if (HASNEXT) {
        constexpr int VPER = (DK == 64) ? 6 : 4;
#pragma unroll
        for (int g = 0; g < 2 * A::NDS; ++g) { __builtin_amdgcn_sched_group_barrier(0x008, 1, 0); __builtin_amdgcn_sched_group_barrier(0x002, VPER, 0); }
    }
    asm volatile("" : "+v"(l));
    __builtin_amdgcn_sched_barrier(0);
#pragma unroll
    for (int j = 2; j < 4; ++j) {
        vlo[j][0] = vtr(Vb + aoffv + j * 16 * A::VSTR); vhi[j][0] = vtr(Vb + aoffv + (j * 16 + 8) * A::VSTR);
        vlo[j][1] = vtr(Vb + aoffv + j * 16 * A::VSTR + 64); vhi[j][1] = vtr(Vb + aoffv + (j * 16 + 8) * A::VSTR + 64);
    }
#pragma unroll
    for (int j = 0; j < 4; ++j) {
        const bf16x8 a0 = __builtin_shufflevector(vlo[j][0], vhi[j][0], 0, 1, 2, 3, 4, 5, 6, 7);
        const bf16x8 a1 = __builtin_shufflevector(vlo[j][1], vhi[j][1], 0, 1, 2, 3, 4, 5, 6, 7);
        o0 = __builtin_amdgcn_mfma_f32_32x32x16_bf16(a0, pb[j], o0, 0, 0, 0);
        o1 = __builtin_amdgcn_mfma_f32_32x32x16_bf16(a1, pb[j], o1, 0, 0, 0);
    }
    if (HASNEXT) {
#pragma unroll
        for (int i = 0; i < 16; ++i) { N0[i] = __builtin_amdgcn_exp2f(N0[i]); N1[i] = __builtin_amdgcn_exp2f(N1[i]); }
#pragma unroll
        for (int g = 0; g < 8; ++g) { __builtin_amdgcn_sched_group_barrier(0x008, 1, 0); __builtin_amdgcn_sched_group_barrier(0x002, 4, 0); }
    }
    __builtin_amdgcn_sched_barrier(0);
    __builtin_amdgcn_s_setprio(0);
    if (STK) { LAS unsigned char* Kn = lds + PAR * A::KBUF; *(LAS u32x4*)(Kn + kl0) = stk0; if (has1) *(LAS u32x4*)(Kn + kl1) = stk1; }
    if (HASNEXT) { LAS unsigned char* Vn = lds + 2 * A::KBUF + (PAR ^ 1) * A::VBUF; *(LAS u32x4*)(Vn + vl) = stv; }
    asm volatile("s_waitcnt lgkmcnt(0)\n\ts_barrier" ::: "memory");
}

template <int DK>
__device__ __forceinline__ void attn_unit(LAS unsigned char* lds, const bf16_t* Qp, int qpitch, const bf16_t* Kp, int kpitch, const bf16_t* Vp, int vpitch, bf16_t* Op, int nt) {
    using A = AttnCtx<DK>;
    constexpr int KSTR = A::KSTR, VSTR = A::VSTR, NDS = A::NDS, KCH = A::KCH, KBUF = A::KBUF;
    int tid_ = threadIdx.x; asm volatile("" : "+v"(tid_));
    const int tid = tid_, lane = tid & 63, wid = tid >> 6, r32 = lane & 31, hi = lane >> 5;
    bf16x8 qf[NDS];
    {
        const bf16_t* qrow = Qp + (size_t)(wid * 32 + r32) * qpitch + 8 * hi;
#pragma unroll
        for (int ds = 0; ds < NDS; ++ds) qf[ds] = *(const bf16x8*)(qrow + ds * 16);
    }
    const int kr0 = tid / KCH, kc0 = tid % KCH;
    const int c1 = tid + NTHREADS; const bool has1 = (DK == 96) && (c1 < 64 * KCH);
    const int kr1 = has1 ? c1 / KCH : 0, kc1 = has1 ? c1 % KCH : 0;
    const int vd = tid >> 3, vc = tid & 7;
    const bf16_t* kg0 = Kp + (size_t)kr0 * kpitch + kc0 * 8;
    const bf16_t* kg1 = Kp + (size_t)kr1 * kpitch + kc1 * 8;
    const bf16_t* vg = Vp + (size_t)vd * vpitch + vc * 8;
    const size_t kstep = (size_t)64 * kpitch, vstep = (size_t)64 * vpitch;
    const int kl0 = kr0 * KSTR + kc0 * 16, kl1 = kr1 * KSTR + kc1 * 16, vl = vd * VSTR + vc * 16;
    const int aoffk = r32 * KSTR + hi * 16;
    const int aoffv = (4 * hi + ((lane & 15) >> 2)) * VSTR + (((lane >> 4) & 1) * 16 + (lane & 3) * 4) * 2;
    {
        const u32x4 a0 = *(const u32x4*)kg0, b0 = *(const u32x4*)(kg0 + kstep), v0 = *(const u32x4*)vg;
        u32x4 a1 = {0u, 0u, 0u, 0u}, b1 = {0u, 0u, 0u, 0u};
        if (has1) { a1 = *(const u32x4*)kg1; b1 = *(const u32x4*)(kg1 + kstep); }
        *(LAS u32x4*)(lds + kl0) = a0; *(LAS u32x4*)(lds + KBUF + kl0) = b0; *(LAS u32x4*)(lds + 2 * KBUF + vl) = v0;
        if (has1) { *(LAS u32x4*)(lds + kl1) = a1; *(LAS u32x4*)(lds + KBUF + kl1) = b1; }
    }
    u32x4 rkA0 = {0u, 0u, 0u, 0u}, rkA1 = {0u, 0u, 0u, 0u}, rvA = {0u, 0u, 0u, 0u}, rkB0, rkB1 = {0u, 0u, 0u, 0u}, rvB;
    rkB0 = *(const u32x4*)(kg0 + 2 * kstep); if (has1) rkB1 = *(const u32x4*)(kg1 + 2 * kstep); rvB = *(const u32x4*)(vg + vstep);
    __syncthreads();
    f32x16 o0, o1, cA0, cA1, cB0, cB1;
#pragma unroll
    for (int i = 0; i < 16; ++i) { o0[i] = 0.f; o1[i] = 0.f; cA0[i] = 0.f; cA1[i] = 0.f; }
#pragma unroll
    for (int ds = 0; ds < NDS; ++ds) {
        const bf16x8 a0 = *(const LAS bf16x8*)(lds + aoffk + ds * 32);
        const bf16x8 a1 = *(const LAS bf16x8*)(lds + aoffk + 32 * KSTR + ds * 32);
        cA0 = __builtin_amdgcn_mfma_f32_32x32x16_bf16(a0, qf[ds], cA0, 0, 0, 0);
        cA1 = __builtin_amdgcn_mfma_f32_32x32x16_bf16(a1, qf[ds], cA1, 0, 0, 0);
    }
#pragma unroll
    for (int i = 0; i < 16; ++i) { cA0[i] = __builtin_amdgcn_exp2f(cA0[i]); cA1[i] = __builtin_amdgcn_exp2f(cA1[i]); }
    __syncthreads();
    float l = 0.f;
    int t = 0;
#define ATT_EVEN(c0_, c1_, n0_, n1_, tt_) lds, c0_, c1_, n0_, n1_, o0, o1, l, qf, kg0, kg1, vg, kstep, vstep, tt_, has1, kl0, kl1, vl, aoffk, aoffv, rkA0, rkA1, rvA, rkB0, rkB1, rvB
#define ATT_ODD(c0_, c1_, n0_, n1_, tt_) lds, c0_, c1_, n0_, n1_, o0, o1, l, qf, kg0, kg1, vg, kstep, vstep, tt_, has1, kl0, kl1, vl, aoffk, aoffv, rkB0, rkB1, rvB, rkA0, rkA1, rvA
    for (; t + 4 < nt; t += 2) {
        attn_step<DK, 0, true, true, true, true>(ATT_EVEN(cA0, cA1, cB0, cB1, t));
        attn_step<DK, 1, true, true, true, true>(ATT_ODD(cB0, cB1, cA0, cA1, t + 1));
    }
    attn_step<DK, 0, true, true, true, true>(ATT_EVEN(cA0, cA1, cB0, cB1, t));
    attn_step<DK, 1, true, false, true, true>(ATT_ODD(cB0, cB1, cA0, cA1, t + 1));
    attn_step<DK, 0, true, false, false, false>(ATT_EVEN(cA0, cA1, cB0, cB1, t + 2));
    attn_step<DK, 1, false, false, false, false>(ATT_ODD(cB0, cB1, cA0, cA1, t + 3));
#undef ATT_EVEN
#undef ATT_ODD
    l = xhalf_add(l);
    const float inv = 1.0f / l;
    bf16_t* orow = Op + (size_t)(wid * 32 + r32) * 1024 + 8 * hi;
#pragma unroll
    for (int db = 0; db < 2; ++db)
#pragma unroll
        for (int k = 0; k < 2; ++k) {
            const f32x16& oo = db == 0 ? o0 : o1;
            const unsigned ax = pk2(oo[8 * k] * inv, oo[8 * k + 1] * inv), ay = pk2(oo[8 * k + 2] * inv, oo[8 * k + 3] * inv);
            const unsigned bx = pk2(oo[8 * k + 4] * inv, oo[8 * k + 5] * inv), by = pk2(oo[8 * k + 6] * inv, oo[8 * k + 7] * inv);
            const auto sx = __builtin_amdgcn_permlane32_swap(ax, bx, false, false), sy = __builtin_amdgcn_permlane32_swap(ay, by, false, false);
            u32x4 w; w.x = sx[0]; w.y = sy[0]; w.z = sx[1]; w.w = sy[1];
            *(u32x4*)(orow + db * 32 + 16 * k) = w;
        }
}

template <int DK>
__device__ __forceinline__ void attn_unit_safe(LAS unsigned char* lds, const bf16_t* Qp, int qpitch, const bf16_t* Kp, int kpitch, const bf16_t* Vp, int vpitch, bf16_t* Op, int nt) {
    constexpr int KSTR = DK * 2 + 16, VSTR = 192, NDS = DK / 16, KCH = DK / 8;
    constexpr int KBUF = 64 * 208, VBUF = 64 * 192;
    int tid_ = threadIdx.x; asm volatile("" : "+v"(tid_));
    const int tid = tid_, lane = tid & 63, wid = tid >> 6, r32 = lane & 31, hi = lane >> 5;
    LAS unsigned char* Kb0 = lds; LAS unsigned char* Vb0 = lds + 2 * KBUF;
    bf16x8 qf[NDS];
    {
        const bf16_t* qrow = Qp + (size_t)(wid * 32 + r32) * qpitch + 8 * hi;
#pragma unroll
        for (int ds = 0; ds < NDS; ++ds) qf[ds] = *(const bf16x8*)(qrow + ds * 16);
    }
    const int kr0 = tid / KCH, kc0 = tid % KCH;
    const int c1 = tid + NTHREADS; const bool has1 = (DK == 96) && (c1 < 64 * KCH);
    const int kr1 = has1 ? c1 / KCH : 0, kc1 = has1 ? c1 % KCH : 0;
    const int vd = tid >> 3, vc = tid & 7;
    const bf16_t* kg0 = Kp + (size_t)kr0 * kpitch + kc0 * 8;
    const bf16_t* kg1 = Kp + (size_t)kr1 * kpitch + kc1 * 8;
    const bf16_t* vg = Vp + (size_t)vd * vpitch + vc * 8;
    const int kl0 = kr0 * KSTR + kc0 * 16, kl1 = kr1 * KSTR + kc1 * 16, vl = vd * VSTR + vc * 16;
    u32x4 rk0, rk1 = {0u, 0u, 0u, 0u}, rv;
    rk0 = *(const u32x4*)kg0; if (has1) rk1 = *(const u32x4*)kg1; rv = *(const u32x4*)vg;
    *(LAS u32x4*)(Kb0 + kl0) = rk0; if (has1) *(LAS u32x4*)(Kb0 + kl1) = rk1; *(LAS u32x4*)(Vb0 + vl) = rv;
    __syncthreads();
    f32x16 o0, o1;
#pragma unroll
    for (int i = 0; i < 16; ++i) { o0[i] = 0.f; o1[i] = 0.f; }
    float m = -1e30f, l = 0.f;
    const int aoffk = r32 * KSTR + hi * 16;
    const int aoffv = (4 * hi + ((lane & 15) >> 2)) * VSTR + (((lane >> 4) & 1) * 16 + (lane & 3) * 4) * 2;
    for (int kt = 0; kt < nt; ++kt) {
        const int cur = kt & 1;
        LAS unsigned char* Kb = Kb0 + cur * KBUF; LAS unsigned char* Vb = Vb0 + cur * VBUF;
        const bool more = kt + 1 < nt;
        if (more) {
            const size_t ko = (size_t)(kt + 1) * 64 * kpitch;
            rk0 = *(const u32x4*)(kg0 + ko); if (has1) rk1 = *(const u32x4*)(kg1 + ko); rv = *(const u32x4*)(vg + (size_t)(kt + 1) * 64 * vpitch);
        }
        f32x16 s0, s1;
#pragma unroll
        for (int i = 0; i < 16; ++i) { s0[i] = 0.f; s1[i] = 0.f; }
#pragma unroll
        for (int ds = 0; ds < NDS; ++ds) {
            const bf16x8 a0 = *(const LAS bf16x8*)(Kb + aoffk + ds * 32);
            const bf16x8 a1 = *(const LAS bf16x8*)(Kb + aoffk + 32 * KSTR + ds * 32);
            s0 = __builtin_amdgcn_mfma_f32_32x32x16_bf16(a0, qf[ds], s0, 0, 0, 0);
            s1 = __builtin_amdgcn_mfma_f32_32x32x16_bf16(a1, qf[ds], s1, 0, 0, 0);
        }
        float mx = fmaxf(s0[0], s1[0]);
#pragma unroll
        for (int i = 1; i < 16; ++i) mx = fmaxf(mx, fmaxf(s0[i], s1[i]));
        mx = xhalf_max(mx);
        const float mnew = fmaxf(m, mx);
        const float alpha = __builtin_amdgcn_exp2f(m - mnew);
        m = mnew;
        float ps = 0.f;
#pragma unroll
        for (int i = 0; i < 16; ++i) { s0[i] = __builtin_amdgcn_exp2f(s0[i] - mnew); s1[i] = __builtin_amdgcn_exp2f(s1[i] - mnew); ps += s0[i] + s1[i]; }
        l = l * alpha + ps;
#pragma unroll
        for (int i = 0; i < 16; ++i) { o0[i] *= alpha; o1[i] *= alpha; }
        bf16x8 pb[4];
        { u32x4 w;
          w.x = pk2(s0[0], s0[1]); w.y = pk2(s0[2], s0[3]); w.z = pk2(s0[4], s0[5]); w.w = pk2(s0[6], s0[7]); pb[0] = __builtin_bit_cast(bf16x8, w);
          w.x = pk2(s0[8], s0[9]); w.y = pk2(s0[10], s0[11]); w.z = pk2(s0[12], s0[13]); w.w = pk2(s0[14], s0[15]); pb[1] = __builtin_bit_cast(bf16x8, w);
          w.x = pk2(s1[0], s1[1]); w.y = pk2(s1[2], s1[3]); w.z = pk2(s1[4], s1[5]); w.w = pk2(s1[6], s1[7]); pb[2] = __builtin_bit_cast(bf16x8, w);
          w.x = pk2(s1[8], s1[9]); w.y = pk2(s1[10], s1[11]); w.z = pk2(s1[12], s1[13]); w.w = pk2(s1[14], s1[15]); pb[3] = __builtin_bit_cast(bf16x8, w); }
#pragma unroll
        for (int j = 0; j < 4; ++j) {
            const s16x4 l0 = vtr(Vb + aoffv + j * 16 * VSTR), h0 = vtr(Vb + aoffv + (j * 16 + 8) * VSTR);
            const s16x4 l1 = vtr(Vb + aoffv + j * 16 * VSTR + 64), h1 = vtr(Vb + aoffv + (j * 16 + 8) * VSTR + 64);
            const bf16x8 a0 = __builtin_shufflevector(l0, h0, 0, 1, 2, 3, 4, 5, 6, 7);
            const bf16x8 a1 = __builtin_shufflevector(l1, h1, 0, 1, 2, 3, 4, 5, 6, 7);
            o0 = __builtin_amdgcn_mfma_f32_32x32x16_bf16(a0, pb[j], o0, 0, 0, 0);
            o1 = __builtin_amdgcn_mfma_f32_32x32x16_bf16(a1, pb[j], o1, 0, 0, 0);
        }
        if (more) {
            LAS unsigned char* Kn = Kb0 + (cur ^ 1) * KBUF; LAS unsigned char* Vn = Vb0 + (cur ^ 1) * VBUF;
            *(LAS u32x4*)(Kn + kl0) = rk0; if (has1) *(LAS u32x4*)(Kn + kl1) = rk1; *(LAS u32x4*)(Vn + vl) = rv;
        }
        __syncthreads();
    }
    l = xhalf_add(l);
    const float inv = 1.0f / l;
    bf16_t* orow = Op + (size_t)(wid * 32 + r32) * 1024 + 4 * hi;
#pragma unroll
    for (int g = 0; g < 4; ++g) {
        u32x2 w; w.x = pk2(o0[4 * g] * inv, o0[4 * g + 1] * inv); w.y = pk2(o0[4 * g + 2] * inv, o0[4 * g + 3] * inv);
        *(u32x2*)(orow + 8 * g) = w;
        w.x = pk2(o1[4 * g] * inv, o1[4 * g + 1] * inv); w.y = pk2(o1[4 * g + 2] * inv, o1[4 * g + 3] * inv);
        *(u32x2*)(orow + 32 + 8 * g) = w;
    }
}

__device__ __forceinline__ void attn_dispatch(const Params& p, LAS unsigned char* lds, int b, int head, int qrow0, int nt, bool fastg, bool fastm) {
    unsigned char* ws = p.ws;
    const size_t rb = (size_t)b * LTOT;
    bf16_t* MIX = (bf16_t*)(ws + OFF_MIX);
    if (head < 6) {
        const int kvh = head / 3;
        const bf16_t* Qp = (const bf16_t*)(ws + OFF_QG) + (rb + qrow0) * 384 + head * 64; const bf16_t* Kp = (const bf16_t*)(ws + OFF_KG) + rb * 128 + kvh * 64;
        const bf16_t* Vp = (const bf16_t*)(ws + OFF_VTG) + rb * 128 + kvh * 64; bf16_t* Op = MIX + (rb + qrow0) * 1024 + head * 64;
        if (fastg) attn_unit<64>(lds, Qp, 384, Kp, 128, Vp, 128, Op, nt); else attn_unit_safe<64>(lds, Qp, 384, Kp, 128, Vp, 128, Op, nt);
    } else {
        const int hm = head - 6;
        const bf16_t* Qp = (const bf16_t*)(ws + OFF_QM) + (rb + qrow0) * 576 + hm * 96; const bf16_t* Kp = (const bf16_t*)(ws + OFF_KM) + rb * 576 + hm * 96;
        const bf16_t* Vp = (const bf16_t*)(ws + OFF_KVRAW) + rb * 768 + hm * 128 + 64; bf16_t* Op = MIX + (rb + qrow0) * 1024 + 384 + hm * 64;
        if (fastm) attn_unit<96>(lds, Qp, 576, Kp, 576, Vp, 768, Op, nt); else attn_unit_safe<96>(lds, Qp, 576, Kp, 576, Vp, 768, Op, nt);
    }
}

__device__ __forceinline__ float absmax_vec(const float* g, int n) { float m = 0.f; for (int i = 0; i < n; ++i) m = fmaxf(m, fabsf(g[i])); return m; }

__device__ __forceinline__ void phase_attn(const Params& p, LAS unsigned char* lds, int G, bool do_ctx, int layer) {
    const float bg = 8.0f * absmax_vec(p.g_q_gqa + layer * 64, 64) * absmax_vec(p.g_k_gqa + layer * 64, 64) * LOG2E * 1.05f;
    const float bm = 9.797959f * absmax_vec(p.g_q_mla + layer * 96, 96) * absmax_vec(p.g_k_mla + layer * 96, 96) * LOG2E * 1.05f;
    const bool fastg = bg < ATT_BMAX, fastm = bm < ATT_BMAX;
    for (int uid = blockIdx.x; uid < 8 * 32 * 12; uid += G) {
        const int b = uid & 7, qb = (uid >> 3) & 31, head = uid >> 8;
        attn_dispatch(p, lds, b, head, LCTX + qb * 256, LTOT / 64, fastg, fastm);
    }
    if (do_ctx)
        for (int uid = blockIdx.x; uid < 8 * 12; uid += G) {
            const int b = uid & 7, head = uid >> 3;
            attn_dispatch(p, lds, b, head, 0, LCTX / 64, fastg, fastm);
        }
}

#define XB_TMO      128
#define XB_XCNT(j)  (256  + 64 * (j))
#define XB_XSUB(j)  (1280 + 64 * (j))
#define XB_XGEN(j)  (2304 + 64 * (j))
#define XB_TOP      3328
#define XB_TOPGEN   3392
#define XCD_BAR_WORDS 3456
#define XB_SPIN_CAP (1u << 18)

__device__ __forceinline__ unsigned xb_ld(unsigned* p)              { return __hip_atomic_load(p, __ATOMIC_RELAXED, __HIP_MEMORY_SCOPE_AGENT); }
__device__ __forceinline__ unsigned xb_add(unsigned* p, unsigned v) { return __hip_atomic_fetch_add(p, v, __ATOMIC_RELAXED, __HIP_MEMORY_SCOPE_AGENT); }
__device__ __forceinline__ unsigned xb_xcc_id() { return (unsigned)__builtin_amdgcn_s_getreg((3 << 11) | 20) & 0xFu; }
#define XB_SPIN(cond, bar) do { unsigned _sp = 0; while (cond) { __builtin_amdgcn_s_sleep(1); \
    if ((++_sp & 255u) == 0u) { if (xb_ld(&(bar)[XB_TMO])) break; if (_sp > XB_SPIN_CAP) { atomicAdd(&(bar)[XB_TMO], 1u); break; } } } } while (0)

struct XcdBarrier {
    unsigned* bar; unsigned x;
    volatile LAS unsigned* st;
};

__device__ __forceinline__ XcdBarrier xcd_barrier_post(unsigned* bar, volatile LAS unsigned* st) {
    XcdBarrier b; b.bar = bar; b.x = xb_xcc_id(); b.st = st;
    if (threadIdx.x == 0) (void)xb_add(&bar[XB_XCNT(b.x)], 1u);
    return b;
}
__device__ __forceinline__ void xcd_barrier_complete(unsigned* bar, unsigned x, unsigned& nloc, unsigned& nx) {
    const unsigned G = gridDim.x * gridDim.y * gridDim.z;
    unsigned sum, cnt, mine, sp = 0u;
    for (;;) {
        sum = 0u; cnt = 0u; mine = 0u;
#pragma unroll
        for (unsigned j = 0; j < 16; ++j) { const unsigned c = xb_ld(&bar[XB_XCNT(j)]); sum += c; cnt += (c > 0u) ? 1u : 0u; mine = (j == x) ? c : mine; }
        if (sum == G) break;
        __builtin_amdgcn_s_sleep(1);
        if ((++sp & 255u) == 0u) { if (xb_ld(&bar[XB_TMO])) break; if (sp > XB_SPIN_CAP) { atomicAdd(&bar[XB_TMO], 1u); break; } }
    }
    nloc = mine > 0u ? mine : 1u; nx = cnt > 0u ? cnt : 1u;
}

__device__ __forceinline__ void xcd_barrier(const XcdBarrier& b) {
    asm volatile("s_waitcnt vmcnt(0)" ::: "memory");
    __syncthreads();
    if (threadIdx.x == 0) {
        unsigned* bar = b.bar;
        __builtin_amdgcn_s_waitcnt(0);
        unsigned nloc = b.st[0], nx = b.st[1];
        if (nloc == 0u) { xcd_barrier_complete(bar, b.x, nloc, nx); b.st[0] = nloc; b.st[1] = nx; }
        const unsigned old = xb_add(&bar[XB_XSUB(b.x)], 1u);
        const unsigned gen = old / nloc;
        if (old + 1u == (gen + 1u) * nloc) {
            __builtin_amdgcn_fence(__ATOMIC_RELEASE, "agent");
            asm volatile("s_waitcnt vmcnt(0)" ::: "memory");
            const unsigned og = xb_add(&bar[XB_TOP], 1u);
            const unsigned tg = og / nx;
            if (og + 1u == (tg + 1u) * nx) xb_add(&bar[XB_TOPGEN], 1u);
            else XB_SPIN(xb_ld(&bar[XB_TOPGEN]) == tg, bar);
            __builtin_amdgcn_fence(__ATOMIC_ACQUIRE, "agent");
            xb_add(&bar[XB_XGEN(b.x)], 1u);
            asm volatile("s_waitcnt vmcnt(0)" ::: "memory");
        } else {
            XB_SPIN(xb_ld(&bar[XB_XGEN(b.x)]) == gen, bar);
            __builtin_amdgcn_fence(__ATOMIC_ACQUIRE, "agent");
            asm volatile("s_waitcnt vmcnt(0)" ::: "memory");
        }
    }
    __syncthreads();
}

__global__ void __launch_bounds__(NTHREADS, 2) mega_fwd(Params p) {
    extern __shared__ __attribute__((aligned(16))) unsigned char lds_raw[];
    LAS unsigned char* lds = (LAS unsigned char*)lds_raw;
    cg::grid_group grid = cg::this_grid();
    const int G = gridDim.x;
    const int ngw = G * NWAVES;
#define FRESH_IDS() int tid = threadIdx.x; asm volatile("" : "+v"(tid)); const int lane = tid & 63, gw = blockIdx.x * NWAVES + (tid >> 6)
    unsigned char* ws = p.ws;
    float* xctx = (float*)(ws + OFF_XCTX);
    const float* modall = (const float*)(ws + OFF_MOD);
    bf16_t* H = (bf16_t*)(ws + OFF_H);

#ifndef NO_PRO
    if (threadIdx.x < 2) ((LAS unsigned*)(lds + 131072))[threadIdx.x] = 0u;
    __syncthreads();
    (void)xcd_barrier_post((unsigned*)(ws + OFF_BAR), (volatile LAS unsigned*)(lds + 131072));
#define GSYNC() do { XcdBarrier b_; b_.bar = (unsigned*)(p.ws + OFF_BAR); b_.x = xb_xcc_id(); b_.st = (volatile LAS unsigned*)(lds + 131072); xcd_barrier(b_); } while (0)
    phase_prologue(p, lds, G);
#endif
    if (p.ws == nullptr) grid.sync();
    GSYNC();
    phase_modfinal(p, G);
    GSYNC();

    for (int layer = 0; layer < DEPTH; ++layer) {
        const float* mod = modall + (size_t)layer * 9 * NMOD;
        const float* src_lat = layer == 0 ? p.x : p.out;
        const float* src_ctx = layer == 0 ? p.ctx : xctx;
        { FRESH_IDS(); phase_norm(src_lat, src_ctx, p.g_norm1 + layer * DM, mod, 0, DM, H, gw, ngw, lane); }
        GSYNC();
#ifndef NO_G1
        {
            pg8::Gemm g{H, (const bf16_t*)(ws + OFF_WIN) + (size_t)layer * UW * DM, NR, UW, DM};
            pg8::StaticOrder S; S.init(NR, UW, G, (int)blockIdx.x);
            pg8::EpiBf16<0> E{(bf16_t*)(ws + OFF_U), UW, 0, nullptr, 1312};
            pg8::gemm_phase<pg8::EpiBf16<0>, pg8::StaticOrder, true, true>(lds, g, S, E);
        }
#endif
        GSYNC();
#ifndef NO_PREP
        { FRESH_IDS(); phase_prep1(p, layer, gw, ngw, lane); }
#endif
        GSYNC();
#ifndef NO_G2
        {
            pg8::Gemm g{(const bf16_t*)(ws + OFF_CQN), (const bf16_t*)(ws + OFF_WUQ) + (size_t)layer * 768 * 256, NR, 768, 256};
            pg8::StaticOrder S; S.init(NR, 768, G, (int)blockIdx.x);
            pg8::EpiBf16<0> E{(bf16_t*)(ws + OFF_QMRAW), 768, 0, nullptr, 576};
            pg8::gemm_phase<pg8::EpiBf16<0>, pg8::StaticOrder, true, true>(lds, g, S, E);
        }
#endif
#ifndef NO_G3
        {
            pg8::Gemm g{(const bf16_t*)(ws + OFF_CKVN), (const bf16_t*)(ws + OFF_WUKV) + (size_t)layer * 768 * 128, NR, 768, 128};
            pg8::StaticOrder S; S.init(NR, 768, G, (int)blockIdx.x);
            pg8::EpiBf16<0> E{(bf16_t*)(ws + OFF_KVRAW), 768, 0, nullptr, 768};
            pg8::gemm_phase<pg8::EpiBf16<0>, pg8::StaticOrder, true, true>(lds, g, S, E);
        }
#endif
        GSYNC();
#ifndef NO_PREP
        { FRESH_IDS(); phase_prep2(p, layer, gw, ngw, lane); }
#endif
        GSYNC();
#ifndef NO_ATTN
        phase_attn(p, lds, G, layer != DEPTH - 1, layer);
#endif
        GSYNC();
#ifndef NO_G5
        {
            pg8::Gemm g{(const bf16_t*)(ws + OFF_MIX), (const bf16_t*)(ws + OFF_WOUT) + (size_t)layer * DM * DM, NR, DM, DM};
            pg8::StaticOrder S; S.init(NR, DM, G, (int)blockIdx.x, layer == DEPTH - 1);
            pg8::EpiResid E{src_lat, src_ctx, p.out, xctx, mod + 2 * DM};
            pg8::gemm_phase<pg8::EpiResid, pg8::StaticOrder, true, true>(lds, g, S, E);
        }
#endif
        GSYNC();
        { FRESH_IDS(); phase_norm(p.out, xctx, p.g_norm2 + layer * DM, mod, 3 * DM, 4 * DM, H, gw, ngw, lane); }
        GSYNC();
#ifndef NO_G6
        {
            pg8::Gemm g{H, (const bf16_t*)(ws + OFF_W1) + (size_t)layer * DFF * DM, NR, DFF, DM};
            pg8::StaticOrder S; S.init(NR, DFF, G, (int)blockIdx.x, layer == DEPTH - 1);
            pg8::EpiBf16<2> E{(bf16_t*)(ws + OFF_A1), DFF, 0, nullptr, DFF};
            pg8::gemm_phase<pg8::EpiBf16<2>, pg8::StaticOrder, true, true>(lds, g, S, E);
        }
#endif
        GSYNC();
#ifndef NO_G7
        {
            pg8::Gemm g{(const bf16_t*)(ws + OFF_A1), (const bf16_t*)(ws + OFF_W2) + (size_t)layer * DM * DFF, NR, DM, DFF};
            pg8::StaticOrder S; S.init(NR, DM, G, (int)blockIdx.x, layer == DEPTH - 1);
            pg8::EpiResid E{p.out, xctx, p.out, xctx, mod + 5 * DM};
            pg8::gemm_phase<pg8::EpiResid, pg8::StaticOrder, true, true>(lds, g, S, E);
        }
#endif
        GSYNC();
    }
}

extern "C" void kernel_launch(void* const* d_in, const int* in_sizes, int n_in, void* d_out, int out_size, void* d_ws, size_t ws_size, hipStream_t stream) {
    static int grid_blocks = 0;
    if (grid_blocks == 0) {
        if (n_in != 22 || ws_size < WS_NEED) { fprintf(stderr, "kernel_launch: need 22 inputs and %zu bytes of workspace; got %d inputs, %zu bytes\n", (size_t)WS_NEED, n_in, ws_size); grid_blocks = -1; return; }
        int dev = 0, cus = 0, per_cu = 0;
        hipGetDevice(&dev);
        hipDeviceGetAttribute(&cus, hipDeviceAttributeMultiprocessorCount, dev);
        hipFuncSetAttribute((const void*)mega_fwd, hipFuncAttributeMaxDynamicSharedMemorySize, LDS_BYTES);
        hipOccupancyMaxActiveBlocksPerMultiprocessor(&per_cu, (const void*)mega_fwd, NTHREADS, LDS_BYTES);
        if (per_cu < 1) per_cu = 1;
        (void)hipGetLastError();
        grid_blocks = cus * per_cu;
        if (grid_blocks > 256) grid_blocks = 256;
    }
    if (grid_blocks < 0) return;
    Params p{};
    p.x = (const float*)d_in[0]; p.c = (const float*)d_in[1]; p.ctx = (const float*)d_in[2]; p.c_ctx = (const float*)d_in[3];
    p.w_mod = (const float*)d_in[4]; p.b_mod = (const float*)d_in[5]; p.g_norm1 = (const float*)d_in[6]; p.g_norm2 = (const float*)d_in[7];
    p.w_in = (const float*)d_in[8]; p.g_q_gqa = (const float*)d_in[9]; p.g_k_gqa = (const float*)d_in[10]; p.g_cq = (const float*)d_in[11]; p.g_ckv = (const float*)d_in[12];
    p.w_uq = (const float*)d_in[13]; p.w_ukv = (const float*)d_in[14]; p.g_q_mla = (const float*)d_in[15]; p.g_k_mla = (const float*)d_in[16];
    p.w_pool = (const float*)d_in[17]; p.ls_pool = (const float*)d_in[18]; p.w_out = (const float*)d_in[19]; p.w_mlp1 = (const float*)d_in[20]; p.w_mlp2 = (const float*)d_in[21];
    p.out = (float*)d_out; p.ws = (unsigned char*)d_ws;
    (void)hipMemsetAsync((unsigned char*)d_ws + OFF_BAR, 0, XCD_BAR_WORDS * 4, stream);
    void* args[] = {&p};
    hipError_t e = hipLaunchCooperativeKernel((const void*)mega_fwd, dim3(grid_blocks), dim3(NTHREADS), args, LDS_BYTES, stream);
    if (e != hipSuccess) fprintf(stderr, "cooperative launch failed: %s (grid %d)\n", hipGetErrorString(e), grid_blocks);
}
```

```cpp
#include <hip/hip_runtime.h>
#include <hip/hip_cooperative_groups.h>
#include <cstdio>
#include <cstdint>
namespace cg = cooperative_groups;
namespace pg8 {
#define PG8_LAS __attribute__((address_space(3)))
typedef unsigned short bf16_t;
typedef short bf16x8 __attribute__((ext_vector_type(8)));
typedef float f32x4 __attribute__((ext_vector_type(4)));
typedef unsigned u32x4 __attribute__((ext_vector_type(4)));
constexpr int BM = 256, BK = 64, HALF = 128, HTB = HALF * BK * 2  , STAGE_BYTES = 8 * HTB, NXCD = 8, WGM = 8;

__host__ __device__ __forceinline__ int lds_byte(int r, int c) { const int st = (r >> 4) * 2 + (c >> 5), rr = r & 15, cc = c & 31, ob = rr * 64 + cc * 2; return st * 1024 + (ob ^ (((ob >> 9) & 1) << 5)); }
__host__ __device__ __forceinline__ void stage_rc(int b, int& R, int& C) { const int st = b / 1024, sb = b % 1024, swz = sb ^ (((sb >> 9) & 1) << 5); R = (st >> 1) * 16 + swz / 64; C = (st & 1) * 32 + (swz % 64) / 2; }
__host__ __device__ __forceinline__ int perm32(int rho) { const int n = rho >> 4, i = rho & 15; return 8 * (i >> 2) + 4 * n + (i & 3); }

struct Unit { int pm, pn, ks; };
struct Gemm { const bf16_t* A; const bf16_t* Bt; int M, N, K, ld; };

struct StaticOrder {
    int nM, nN, nwg, G, c, skipctx;
    __host__ __device__ void init(int M, int N, int G_, int c_, int skipctx_ = 0) { nM = M / BM; if (skipctx_) nM -= nM / 33; nN = N / BM; nwg = nM * nN; G = G_; c = c_; skipctx = skipctx_; }
    __host__ __device__ bool next(int i, Unit& u) const {
        const long L = (long)i * G + c; if (L >= nwg) return false;
        int wgid = (int)L; { const int q = nwg / NXCD, r = nwg % NXCD, xcd = wgid % NXCD, off = wgid / NXCD; wgid = (xcd < r ? xcd * (q + 1) : r * (q + 1) + (xcd - r) * q) + off; }
        const int nig = WGM * nN, gid = wgid / nig, fm = gid * WGM, gsz = (nM - fm) < WGM ? (nM - fm) : WGM;
        u.pm = fm + ((wgid % nig) % gsz); u.pn = (wgid % nig) / gsz; u.ks = 0; if (skipctx) u.pm += u.pm / 32 + 1; return true;
    }
    __device__ __forceinline__ void a_ready(const Unit&) const {}
    __device__ __forceinline__ void done(const Unit&) const {}
};
struct SplitKCtx {
    int G, c;
    __host__ __device__ void init(int G_, int c_) { G = G_; c = c_; }
    __host__ __device__ bool next(int i, Unit& u) const { const int L = i * G + c; if (L >= 256) return false; u.ks = L & 7; u.pn = (L >> 3) & 3; u.pm = (L >> 5) * 33; return true; }
    __device__ __forceinline__ void a_ready(const Unit&) const {}
    __device__ __forceinline__ void done(const Unit&) const {}
};


__device__ __forceinline__ unsigned cvt_pk_bf16(float lo, float hi) { unsigned r; asm volatile("v_cvt_pk_bf16_f32 %0, %1, %2" : "=v"(r) : "v"(lo), "v"(hi)); return r; }
typedef float f32x2 __attribute__((ext_vector_type(2)));
typedef float f32x2_t __attribute__((ext_vector_type(2)));
typedef __bf16 bf16x2_t __attribute__((ext_vector_type(2)));
__device__ __forceinline__ unsigned pk2(float lo, float hi) { f32x2_t v = {lo, hi}; bf16x2_t b = __builtin_convertvector(v, bf16x2_t); return __builtin_bit_cast(unsigned, b); }

template <int ACT, bool SCALE = false> struct EpiBf16 {
    static constexpr bool PERM = true, AFTER_DRAIN = false;
    bf16_t* O; int ldc; int coloff; const float* colscale; int nvalid;
    __device__ __forceinline__ void operator()(const f32x4 (&acc)[2][2][4][2], const Unit& u, int wr, int wc, int fr, int fq) const {
        const int row0 = u.pm * BM + wr * 64 + fr;
        const int col0 = u.pn * BM + wc * 32 + 8 * fq;
        f32x4 cs[2][2];
        if (SCALE) {
#pragma unroll
            for (int bj = 0; bj < 2; ++bj)
#pragma unroll
                for (int n = 0; n < 2; ++n) cs[bj][n] = *(const f32x4*)(colscale + col0 + bj * HALF + 4 * n);
        }
#pragma unroll
        for (int ai = 0; ai < 2; ++ai)
#pragma unroll
            for (int m = 0; m < 4; ++m) { bf16_t* rowp = O + (size_t)(row0 + ai * HALF + m * 16) * ldc + coloff + col0;
#pragma unroll
                for (int bj = 0; bj < 2; ++bj) { f32x4 v0 = acc[ai][bj][m][0], v1 = acc[ai][bj][m][1];
                    if (ACT == 2) {
#pragma unroll
                        for (int e = 0; e < 4; ++e) { float a = fmaxf(v0[e], 0.f), b = fmaxf(v1[e], 0.f); v0[e] = a * a; v1[e] = b * b; } }
                    if (SCALE) { v0 = v0 * cs[bj][0]; v1 = v1 * cs[bj][1]; }
                    u32x4 w; w.x = pk2(v0[0], v0[1]); w.y = pk2(v0[2], v0[3]); w.z = pk2(v1[0], v1[1]); w.w = pk2(v1[2], v1[3]);
                    if (col0 + bj * HALF < nvalid) *(u32x4*)(rowp + bj * HALF) = w; } }
    }
};

struct EpiResid {
    static constexpr bool PERM = true, AFTER_DRAIN = false;
    const float* src_lat; const float* src_ctx; float* dst_lat; float* dst_ctx; const float* gate;
    __device__ __forceinline__ void operator()(const f32x4 (&acc)[2][2][4][2], const Unit& u, int wr, int wc, int fr, int fq) const {
        const int b = u.pm / 33, j = u.pm - b * 33;
        const float* sb; float* db; const float* g;
        if (j == 0) { sb = src_ctx + (size_t)b * 256 * 1024; db = dst_ctx + (size_t)b * 256 * 1024; g = gate + 8 * 6144; }
        else { const size_t o = ((size_t)b * 8192 + (size_t)(j - 1) * 256) * 1024; sb = src_lat + o; db = dst_lat + o; g = gate + b * 6144; }
        const int col0 = u.pn * BM + wc * 32 + 8 * fq;
        f32x4 gv[2][2];
#pragma unroll
        for (int bj = 0; bj < 2; ++bj)
#pragma unroll
            for (int n = 0; n < 2; ++n) gv[bj][n] = *(const f32x4*)(g + col0 + bj * HALF + n * 4);
#pragma unroll
        for (int ai = 0; ai < 2; ++ai)
#pragma unroll
            for (int m = 0; m < 4; ++m) { const size_t off = (size_t)(ai * HALF + wr * 64 + m * 16 + fr) * 1024 + col0;
#pragma unroll
                for (int bj = 0; bj < 2; ++bj)
#pragma unroll
                    for (int n = 0; n < 2; ++n) { const f32x4 bs = *(const f32x4*)(sb + off + bj * HALF + n * 4);
                        *(f32x4*)(db + off + bj * HALF + n * 4) = bs + gv[bj][n] * acc[ai][bj][m][n]; }
                if (m == 3) asm volatile("" ::: "memory"); }
    }
};

struct EpiPartial {
    static constexpr bool PERM = false, AFTER_DRAIN = false;
    float* P;
    __device__ __forceinline__ void operator()(const f32x4 (&acc)[2][2][4][2], const Unit& u, int wr, int wc, int fr, int fq) const {
        float* base = P + ((size_t)u.ks * 2048 + (size_t)(u.pm / 33) * 256) * 1024;
        const int col0 = u.pn * BM + wc * 32 + 4 * fq;
#pragma unroll
        for (int ai = 0; ai < 2; ++ai)
#pragma unroll
            for (int m = 0; m < 4; ++m) { const size_t off = (size_t)(ai * HALF + wr * 64 + m * 16 + fr) * 1024 + col0;
#pragma unroll
                for (int bj = 0; bj < 2; ++bj)
#pragma unroll
                    for (int n = 0; n < 2; ++n) *(f32x4*)(base + off + bj * HALF + n * 16) = acc[ai][bj][m][n]; }
    }
};

template <class Epi, class Sched, bool ALIGN_EPI = false, bool SP2 = false>
__device__ __forceinline__ void gemm_phase(PG8_LAS unsigned char* lds, const Gemm g, const Sched& S, const Epi& E) {
    int tid_ = threadIdx.x; asm volatile("" : "+v"(tid_));
    const int tid = tid_, wid = __builtin_amdgcn_readfirstlane(tid >> 6), lane = tid & 63, wr = wid >> 2, wc = wid & 3, fr = lane & 15, fq = lane >> 4;
    const int K = g.K, nt = K / BK, LD = g.ld ? g.ld : g.K;
    const size_t sstep = (size_t)K * 2;
    unsigned voffA[2], voffB[2];
#pragma unroll
    for (int i = 0; i < 2; ++i) { int R, C; stage_rc(tid * 16 + i * 8192, R, C); const int Rb = Epi::PERM ? ((R & ~31) + perm32(R & 31)) : R;
        voffA[i] = (unsigned)(R * LD + C) * 2u; voffB[i] = (unsigned)(Rb * LD + C) * 2u; }
    const size_t kstep = (size_t)(BK * 2);
    const size_t hstep = (size_t)HALF * LD * 2;
    const size_t tstep = 2 * hstep;
    const unsigned ldsw = (unsigned)wid * 1024u;
    const int aoff = lds_byte(wr * 64 + fr, fq * 8), boff = lds_byte(wc * 32 + fr, fq * 8);
#define PG8_SA(b, h) (((b) * 2 + (h)) * HTB)
#define PG8_SB(b, h) ((4 + (b) * 2 + (h)) * HTB)
#define PG8_STAGE(bufoff, gbase, voff) do { _Pragma("unroll") for (int _i = 0; _i < 2; ++_i) \
        __builtin_amdgcn_global_load_lds((const unsigned*)((const char*)(gbase) + (voff)[_i]), (PG8_LAS unsigned*)(lds + (bufoff) + ldsw + _i * 8192), 16, 0, 0); } while (0)
#define PG8_LDA(dst, b, h) do { _Pragma("unroll") for (int m = 0; m < 4; ++m) _Pragma("unroll") for (int k = 0; k < 2; ++k) dst[m][k] = *(const PG8_LAS bf16x8*)(lds + PG8_SA(b, h) + aoff + m * 2048 + k * 1024); } while (0)
#define PG8_LDB(dst, b, h) do { _Pragma("unroll") for (int n = 0; n < 2; ++n) _Pragma("unroll") for (int k = 0; k < 2; ++k) dst[n][k] = *(const PG8_LAS bf16x8*)(lds + PG8_SB(b, h) + boff + n * 2048 + k * 1024); } while (0)
#define PG8_MMA(ai, bj, At, Bt) do { __builtin_amdgcn_s_setprio(1); _Pragma("unroll") for (int m = 0; m < 4; ++m) _Pragma("unroll") for (int n = 0; n < 2; ++n) _Pragma("unroll") for (int k = 0; k < 2; ++k) \
        acc[ai][bj][m][n] = __builtin_amdgcn_mfma_f32_16x16x32_bf16(Bt[n][k], At[m][k], acc[ai][bj][m][n], 0, 0, 0); __builtin_amdgcn_s_setprio(0); } while (0)
#define PG8_WAIT_V(n) asm volatile("s_waitcnt vmcnt(" #n ")" ::: "memory")
#define PG8_WAIT_L(n) asm volatile("s_waitcnt lgkmcnt(" #n ")" ::: "memory")
#define PG8_BAR __builtin_amdgcn_s_barrier()
#define PG8_SCHED __builtin_amdgcn_sched_barrier(0)
    Unit cur, nxt; int ui = 0;
    if (!S.next(0, cur)) return;
    f32x4 acc[2][2][4][2];
#pragma unroll
    for (int a = 0; a < 2; ++a)
#pragma unroll
        for (int b = 0; b < 2; ++b)
#pragma unroll
            for (int m = 0; m < 4; ++m)
#pragma unroll
                for (int n = 0; n < 2; ++n) acc[a][b][m][n] = (f32x4){0.f, 0.f, 0.f, 0.f};
    bf16x8 At[4][2], B0[2][2], B1[2][2];
    const char* cA = (const char*)g.A + (size_t)cur.pm * tstep + (size_t)cur.ks * sstep; const char* cB = (const char*)g.Bt + (size_t)cur.pn * tstep + (size_t)cur.ks * sstep;
    S.a_ready(cur);
    if constexpr (SP2) {
        PG8_STAGE(PG8_SB(0, 0), cB, voffB); PG8_STAGE(PG8_SB(0, 1), cB + hstep, voffB); PG8_STAGE(PG8_SA(0, 0), cA, voffA); PG8_STAGE(PG8_SA(0, 1), cA + hstep, voffA);
        if (wr == 1) PG8_BAR;
        PG8_WAIT_V(2); PG8_BAR;
        PG8_STAGE(PG8_SB(1, 0), cB + kstep, voffB); PG8_STAGE(PG8_SA(1, 0), cA + kstep, voffA); PG8_STAGE(PG8_SB(1, 1), cB + hstep + kstep, voffB);
        PG8_WAIT_V(6); PG8_BAR;
    } else {
        PG8_STAGE(PG8_SB(0, 0), cB, voffB); PG8_STAGE(PG8_SA(0, 0), cA, voffA); PG8_STAGE(PG8_SB(0, 1), cB + hstep, voffB); PG8_STAGE(PG8_SA(0, 1), cA + hstep, voffA);
        if (wr == 1) PG8_BAR;
        PG8_WAIT_V(4); PG8_BAR;
        PG8_STAGE(PG8_SB(1, 0), cB + kstep, voffB); PG8_STAGE(PG8_SA(1, 0), cA + kstep, voffA); PG8_STAGE(PG8_SB(1, 1), cB + hstep + kstep, voffB);
        PG8_WAIT_V(6); PG8_BAR;
    }
    for (;;) {
        const bool has_next = S.next(ui + 1, nxt);
        const char* nA = has_next ? (const char*)g.A + (size_t)nxt.pm * tstep + (size_t)nxt.ks * sstep : cA; const char* nB = has_next ? (const char*)g.Bt + (size_t)nxt.pn * tstep + (size_t)nxt.ks * sstep : cB;
        for (int t = 0; t < nt; t += 2) {
            const bool last = (t == nt - 2);
            const char* a1 = cA + (size_t)(t + 1) * kstep;
            const char* a2 = last ? nA : cA + (size_t)(t + 2) * kstep; const char* b2 = last ? nB : cB + (size_t)(t + 2) * kstep;
            const char* a3 = a2 + kstep; const char* b3 = b2 + kstep;
            if (last && has_next) S.a_ready(nxt);
            if constexpr (SP2) {
            PG8_LDB(B0, 0, 0); PG8_LDB(B1, 0, 1); PG8_SCHED; PG8_LDA(At, 0, 0); PG8_STAGE(PG8_SA(1, 1), a1 + hstep, voffA);
            PG8_WAIT_V(8); PG8_WAIT_L(0); PG8_BAR; PG8_MMA(0, 0, At, B0); PG8_MMA(0, 1, At, B1); PG8_BAR; PG8_SCHED;
            PG8_LDA(At, 0, 1); PG8_STAGE(PG8_SB(0, 0), b2, voffB); PG8_STAGE(PG8_SB(0, 1), b2 + hstep, voffB); PG8_STAGE(PG8_SA(0, 0), a2, voffA);
            PG8_WAIT_V(8); PG8_WAIT_L(0); PG8_BAR; PG8_MMA(1, 0, At, B0); PG8_MMA(1, 1, At, B1); PG8_BAR; PG8_SCHED;
            PG8_LDB(B0, 1, 0); PG8_LDB(B1, 1, 1); PG8_SCHED; PG8_LDA(At, 1, 0); PG8_STAGE(PG8_SA(0, 1), a2 + hstep, voffA);
            PG8_WAIT_V(8); PG8_WAIT_L(0); PG8_BAR; PG8_MMA(0, 0, At, B0); PG8_MMA(0, 1, At, B1); PG8_BAR; PG8_SCHED;
            PG8_LDA(At, 1, 1); PG8_STAGE(PG8_SB(1, 0), b3, voffB); PG8_STAGE(PG8_SB(1, 1), b3 + hstep, voffB); PG8_STAGE(PG8_SA(1, 0), a3, voffA);
            PG8_WAIT_V(8); PG8_WAIT_L(0); PG8_BAR; PG8_MMA(1, 0, At, B0); PG8_MMA(1, 1, At, B1); PG8_BAR; PG8_SCHED;
            } else {
            PG8_LDB(B0, 0, 0); PG8_SCHED; PG8_LDA(At, 0, 0); PG8_STAGE(PG8_SA(1, 1), a1 + hstep, voffA);
            PG8_WAIT_L(8); PG8_BAR; PG8_WAIT_L(0); PG8_MMA(0, 0, At, B0); PG8_BAR; PG8_SCHED;
            PG8_LDB(B1, 0, 1); PG8_STAGE(PG8_SB(0, 0), b2, voffB);
            PG8_BAR; PG8_WAIT_L(0); PG8_MMA(0, 1, At, B1); PG8_BAR;
            PG8_LDA(At, 0, 1); PG8_STAGE(PG8_SA(0, 0), a2, voffA);
            PG8_BAR; PG8_WAIT_L(0); PG8_MMA(1, 0, At, B0); PG8_BAR; PG8_SCHED;
            PG8_STAGE(PG8_SB(0, 1), b2 + hstep, voffB);
            PG8_WAIT_V(6); PG8_BAR; PG8_MMA(1, 1, At, B1); PG8_BAR;
            PG8_LDB(B0, 1, 0); PG8_SCHED; PG8_LDA(At, 1, 0); PG8_STAGE(PG8_SA(0, 1), a2 + hstep, voffA);
            PG8_WAIT_L(8); PG8_BAR; PG8_WAIT_L(0); PG8_MMA(0, 0, At, B0); PG8_BAR; PG8_SCHED;
            PG8_LDB(B1, 1, 1); PG8_STAGE(PG8_SB(1, 0), b3, voffB);
            PG8_BAR; PG8_WAIT_L(0); PG8_MMA(0, 1, At, B1); PG8_BAR;
            PG8_LDA(At, 1, 1); PG8_STAGE(PG8_SA(1, 0), a3, voffA);
            PG8_BAR; PG8_WAIT_L(0); PG8_MMA(1, 0, At, B0); PG8_BAR; PG8_SCHED;
            PG8_STAGE(PG8_SB(1, 1), b3 + hstep, voffB);
            PG8_WAIT_V(6); PG8_BAR; PG8_MMA(1, 1, At, B1); PG8_BAR;
            }
        }
        if constexpr (ALIGN_EPI) { if (wr == 0) PG8_BAR; }
        if constexpr (!Epi::AFTER_DRAIN) { int t2_ = tid; asm volatile("" : "+v"(t2_));
            E(acc, cur, wr, wc, t2_ & 15, (t2_ & 63) >> 4); S.done(cur); }
        if (!has_next) break;
#pragma unroll
        for (int a = 0; a < 2; ++a)
#pragma unroll
            for (int b = 0; b < 2; ++b)
#pragma unroll
                for (int m = 0; m < 4; ++m)
#pragma unroll
                    for (int n = 0; n < 2; ++n) acc[a][b][m][n] = (f32x4){0.f, 0.f, 0.f, 0.f};
        cur = nxt; cA = nA; cB = nB; ++ui;
        if constexpr (ALIGN_EPI) { if (wr == 1) PG8_BAR; }
    }
    PG8_WAIT_V(0);
    if constexpr (!ALIGN_EPI) { if (wr == 0) PG8_BAR; }
    PG8_BAR;
    if constexpr (Epi::AFTER_DRAIN) { E.fused(acc, cur, wr, wc, fr, fq, lds, wid, lane); S.done(cur); }
#undef PG8_SA
#undef PG8_SB
#undef PG8_STAGE
#undef PG8_LDA
#undef PG8_LDB
#undef PG8_MMA
#undef PG8_WAIT_V
#undef PG8_WAIT_L
#undef PG8_BAR
#undef PG8_SCHED
}
}

#define LAS __attribute__((address_space(3)))
typedef unsigned short bf16_t;
typedef short bf16x8 __attribute__((ext_vector_type(8)));
typedef float f32x4 __attribute__((ext_vector_type(4)));
typedef float f32x16 __attribute__((ext_vector_type(16)));
typedef unsigned u32x4 __attribute__((ext_vector_type(4)));
typedef unsigned u32x2 __attribute__((ext_vector_type(2)));
using pg8::pk2;

constexpr int NB = 8, LSEQ = 8192, LCTX = 256, LTOT = LSEQ + LCTX, NR = NB * LTOT, DM = 1024, DEPTH = 4, DFF = 4096;
constexpr int UW = 1536;
constexpr int NMOD = 6 * DM;
constexpr float EPS = 1e-6f;
constexpr float LOG2E = 1.4426950408889634f;
constexpr float QSCALE_G = 0.125f * LOG2E;
constexpr float QSCALE_M = 0.10206207261596575f * LOG2E;
constexpr int NWAVES = 8, NTHREADS = 512;
constexpr int LDS_BYTES = 131072 + 512;

constexpr size_t MiB = 1u << 20;
constexpr size_t COLB = (size_t)NR * 2;
constexpr size_t OFF_BAR = 880 * 1024;
constexpr size_t OFF_MOD = 0, OFF_MODP = 1 * MiB, OFF_ROPEG = 5 * MiB, OFF_ROPEM = 7 * MiB, OFF_XCTX = 8 * MiB;
constexpr size_t OFF_WIN = 16 * MiB, OFF_WUQ = 28 * MiB, OFF_WUKV = 30 * MiB, OFF_WPOOL = 31 * MiB, OFF_WOUT = 32 * MiB, OFF_W1 = 40 * MiB, OFF_W2 = 72 * MiB;
constexpr size_t OFF_H = 104 * MiB;
constexpr size_t OFF_R = 236 * MiB;
constexpr size_t OFF_U = OFF_R;
constexpr size_t OFF_QMRAW = OFF_U, OFF_KVRAW = OFF_U + 768 * COLB;
constexpr size_t OFF_CQN = OFF_U + 1536 * COLB;
constexpr size_t OFF_CKVN = OFF_CQN + 256 * COLB;
constexpr size_t OFF_Y = OFF_CKVN + 128 * COLB;
constexpr size_t OFF_KR = OFF_Y + 256 * COLB;
constexpr size_t OFF_QG = OFF_KR + 32 * COLB;
constexpr size_t OFF_KG = OFF_QG + 384 * COLB;
constexpr size_t OFF_VTG = OFF_KG + 128 * COLB;
constexpr size_t OFF_QM = OFF_VTG + 128 * COLB;
constexpr size_t OFF_KM = OFF_QM + 576 * COLB;
constexpr size_t OFF_VTM = OFF_KM + 576 * COLB;
constexpr size_t OFF_MIX = OFF_VTM + 384 * COLB;
constexpr size_t OFF_REND = OFF_MIX + 1024 * COLB;
constexpr size_t OFF_A1 = OFF_R;
constexpr size_t WS_NEED = (OFF_REND > OFF_A1 + 4096 * COLB) ? OFF_REND : OFF_A1 + 4096 * COLB;
static_assert(OFF_MODP + 4 * DEPTH * 9 * NMOD * 4 <= OFF_ROPEG, "ws map");
static_assert(OFF_A1 + 4096 * COLB <= OFF_REND + 1, "A1 inside R");

struct Params {
    const float *x, *c, *ctx, *c_ctx, *w_mod, *b_mod, *g_norm1, *g_norm2, *w_in, *g_q_gqa, *g_k_gqa, *g_cq, *g_ckv, *w_uq, *w_ukv, *g_q_mla, *g_k_mla, *w_pool, *ls_pool, *w_out, *w_mlp1, *w_mlp2;
    float* out; unsigned char* ws;
};

__device__ __forceinline__ float bf2f(unsigned short h) { return __uint_as_float((unsigned)h << 16); }
__device__ __forceinline__ void unpack8(const u32x4 w, float (&v)[8]) {
    v[0] = __uint_as_float(w.x << 16); v[1] = __uint_as_float(w.x & 0xffff0000u); v[2] = __uint_as_float(w.y << 16); v[3] = __uint_as_float(w.y & 0xffff0000u);
    v[4] = __uint_as_float(w.z << 16); v[5] = __uint_as_float(w.z & 0xffff0000u); v[6] = __uint_as_float(w.w << 16); v[7] = __uint_as_float(w.w & 0xffff0000u);
}
__device__ __forceinline__ void unpack4(const u32x2 w, float (&v)[4]) {
    v[0] = __uint_as_float(w.x << 16); v[1] = __uint_as_float(w.x & 0xffff0000u); v[2] = __uint_as_float(w.y << 16); v[3] = __uint_as_float(w.y & 0xffff0000u);
}
__device__ __forceinline__ u32x4 pack8(const float (&v)[8]) { u32x4 w; w.x = pk2(v[0], v[1]); w.y = pk2(v[2], v[3]); w.z = pk2(v[4], v[5]); w.w = pk2(v[6], v[7]); return w; }
template <int M> __device__ __forceinline__ float swz_xor(float v) { return __int_as_float(__builtin_amdgcn_ds_swizzle(__float_as_int(v), (M << 10) | 0x1f)); }
__device__ __forceinline__ float xhalf_add(float v) { auto rr = __builtin_amdgcn_permlane32_swap(__float_as_uint(v), __float_as_uint(v), false, false); return __uint_as_float(rr[0]) + __uint_as_float(rr[1]); }
__device__ __forceinline__ float xhalf_max(float v) { auto rr = __builtin_amdgcn_permlane32_swap(__float_as_uint(v), __float_as_uint(v), false, false); return fmaxf(__uint_as_float(rr[0]), __uint_as_float(rr[1])); }
__device__ __forceinline__ float wave_sum(float v) {
    v += swz_xor<1>(v); v += swz_xor<2>(v); v += swz_xor<4>(v); v += swz_xor<8>(v); v += swz_xor<16>(v);
    return xhalf_add(v);
}
__device__ __forceinline__ int perm16(int p) { return (p & ~12) | ((p & 4) << 1) | ((p & 8) >> 1); }

__device__ __forceinline__ void transpose_item(const float* W, int K, int N, bf16_t* WT, LAS float* scr, int item, int lane) {
    const int nblk = N / 32, kb = item / nblk, nb = item % nblk, k0 = 64 * kb, n0 = 32 * nb;
#pragma unroll 8
    for (int i = 0; i < 32; ++i) { const int kk = 2 * i + (lane >> 5); scr[kk * 33 + (lane & 31)] = W[(size_t)(k0 + kk) * N + n0 + (lane & 31)]; }
    asm volatile("s_waitcnt lgkmcnt(0)" ::: "memory");
    const int c = lane & 7;
#pragma unroll
    for (int j = 0; j < 4; ++j) { const int n = (lane >> 3) + 8 * j; const LAS float* s = scr + (8 * c) * 33 + n;
        u32x4 o; o.x = pk2(s[0 * 33], s[1 * 33]); o.y = pk2(s[2 * 33], s[3 * 33]); o.z = pk2(s[4 * 33], s[5 * 33]); o.w = pk2(s[6 * 33], s[7 * 33]);
        *(u32x4*)(WT + (size_t)(n0 + n) * K + k0 + 8 * c) = o; }
    asm volatile("s_waitcnt lgkmcnt(0)" ::: "memory");
}

__device__ __forceinline__ void phase_prologue(const Params& p, LAS unsigned char* lds, int G) {
    const int tid = threadIdx.x, lane = tid & 63, wid = tid >> 6;
    const int gw = blockIdx.x * NWAVES + wid, ngw = G * NWAVES;
    const int gt = blockIdx.x * NTHREADS + tid, ngt = G * NTHREADS;
    unsigned char* ws = p.ws;
    LAS float* sv = (LAS float*)(lds + 71680);
    for (int i = tid; i < 9 * DM; i += NTHREADS) { const float v = (i < 8 * DM) ? p.c[i] : p.c_ctx[i - 8 * DM]; sv[i] = v / (1.f + __expf(-v)); }
    __syncthreads();
    {
        float* modp = (float*)(ws + OFF_MODP);
        for (int it = gt; it < DEPTH * 4 * NMOD; it += ngt) {
            const int n = it % NMOD, ks = (it / NMOD) & 3, l = it / (4 * NMOD);
            const float* w = p.w_mod + ((size_t)l * DM + ks * 256) * NMOD + n;
            float acc[9];
#pragma unroll
            for (int j = 0; j < 9; ++j) acc[j] = 0.f;
#pragma unroll 2
            for (int k = 0; k < 256; k += 4) {
                const float w0 = w[(size_t)k * NMOD], w1 = w[(size_t)(k + 1) * NMOD], w2 = w[(size_t)(k + 2) * NMOD], w3 = w[(size_t)(k + 3) * NMOD];
#pragma unroll
                for (int j = 0; j < 9; ++j) { const f32x4 s = *(const LAS f32x4*)(sv + j * DM + ks * 256 + k); acc[j] += s.x * w0 + s.y * w1 + s.z * w2 + s.w * w3; }
            }
#pragma unroll
            for (int j = 0; j < 9; ++j) modp[(((size_t)ks * DEPTH + l) * 9 + j) * NMOD + n] = acc[j];
        }
    }
    {
        LAS float* scr = (LAS float*)(lds + wid * 8704);
        constexpr int I_IN = 16 * 41, I_UQ = 4 * 18, I_UKV = 2 * 24, I_OUT = 16 * 32, I_1 = 16 * 128, I_2 = 64 * 32, I_L = I_IN + I_UQ + I_UKV + I_OUT + I_1 + I_2;
        for (int it = gw; it < DEPTH * I_L; it += ngw) {
            const int l = it / I_L; int r = it - l * I_L;
            if (r < I_IN) { transpose_item(p.w_in + (size_t)l * DM * 1312, DM, 1312, (bf16_t*)(ws + OFF_WIN) + (size_t)l * UW * DM, scr, r, lane); continue; } r -= I_IN;
            if (r < I_UQ) { transpose_item(p.w_uq + (size_t)l * 256 * 576, 256, 576, (bf16_t*)(ws + OFF_WUQ) + (size_t)l * 768 * 256, scr, r, lane); continue; } r -= I_UQ;
            if (r < I_UKV) { transpose_item(p.w_ukv + (size_t)l * 128 * 768, 128, 768, (bf16_t*)(ws + OFF_WUKV) + (size_t)l * 768 * 128, scr, r, lane); continue; } r -= I_UKV;
            if (r < I_OUT) { transpose_item(p.w_out + (size_t)l * DM * DM, DM, DM, (bf16_t*)(ws + OFF_WOUT) + (size_t)l * DM * DM, scr, r, lane); continue; } r -= I_OUT;
            if (r < I_1) { transpose_item(p.w_mlp1 + (size_t)l * DM * DFF, DM, DFF, (bf16_t*)(ws + OFF_W1) + (size_t)l * DFF * DM, scr, r, lane); continue; } r -= I_1;
            transpose_item(p.w_mlp2 + (size_t)l * DFF * DM, DFF, DM, (bf16_t*)(ws + OFF_W2) + (size_t)l * DM * DFF, scr, r, lane);
        }
    }
    {
        const u32x4 z = {0u, 0u, 0u, 0u};
        constexpr int ZIN = 224 * DM / 8, ZUQ = 192 * 256 / 8;
        for (int it = gt; it < DEPTH * (ZIN + ZUQ); it += ngt) {
            const int l = it / (ZIN + ZUQ), r = it - l * (ZIN + ZUQ);
            if (r < ZIN) *(u32x4*)((bf16_t*)(ws + OFF_WIN) + (size_t)l * UW * DM + (size_t)1312 * DM + (size_t)r * 8) = z;
            else *(u32x4*)((bf16_t*)(ws + OFF_WUQ) + (size_t)l * 768 * 256 + (size_t)576 * 256 + (size_t)(r - ZIN) * 8) = z;
        }
    }
    {
        bf16_t* wp = (bf16_t*)(ws + OFF_WPOOL);
        for (int it = gt; it < DEPTH * 65536; it += ngt) {
            const int l = it >> 16, n = (it >> 8) & 255, k = it & 255;
            const int g = n >> 6, d = n & 63, g2 = k >> 6, cc = k & 63;
            const float v = (g == g2) ? p.w_pool[(((size_t)l * 4 + g) * 64 + cc) * 64 + d] * p.ls_pool[l * 256 + n] : 0.f;
            wp[it] = (bf16_t)(pk2(v, 0.f) & 0xffffu);
        }
    }
    {
        float* tg = (float*)(ws + OFF_ROPEG); float* tm = (float*)(ws + OFF_ROPEM);
        for (int it = gt; it < LSEQ * 48; it += ngt) {
            const int t = it / 48, j = it - t * 48;
            const int row = t >> 6, col = t & 63;
            double pos, e;
            if (j < 32) { pos = (j < 16) ? (double)row : (double)col; e = (double)(j & 15) / 16.0; }
            else { const int jj = j - 32; pos = (jj < 8) ? (double)row : (double)col; e = (double)(jj & 7) / 8.0; }
            const float inv = (float)exp2(-e * 13.287712379549449);
            const float angf = (float)pos * inv;
            const double a = (double)angf;
            const double kk = rint(a * 0.15915494309189535);
            const float rr = (float)(a - kk * 6.283185307179586);
            const float cs = __cosf(rr), sn = __sinf(rr);
            if (j < 32) { tg[t * 64 + j] = cs; tg[t * 64 + 32 + j] = sn; }
            else { tm[t * 32 + (j - 32)] = cs; tm[t * 32 + 16 + (j - 32)] = sn; }
        }
    }
}

__device__ __forceinline__ void phase_modfinal(const Params& p, int G) {
    const int gt = blockIdx.x * NTHREADS + threadIdx.x, ngt = G * NTHREADS;
    const float* modp = (const float*)(p.ws + OFF_MODP); float* mod = (float*)(p.ws + OFF_MOD);
    constexpr int TOT = DEPTH * 9 * NMOD;
    for (int it = gt; it < TOT; it += ngt) {
        const int n = it % NMOD, l = it / (9 * NMOD);
        mod[it] = p.b_mod[l * NMOD + n] + ((modp[it] + modp[TOT + it]) + (modp[2 * TOT + it] + modp[3 * TOT + it]));
    }
}

__device__ __forceinline__ f32x4 ldg4(const float* p) { return *(const f32x4*)p; }
__device__ __forceinline__ void phase_norm(const float* lat, const float* ctx, const float* g, const float* mod, int shoff, int scoff, bf16_t* H, int gw, int ngw, int lane) {
    constexpr int R = 3;
    f32x4 gg[4];
#pragma unroll
    for (int j = 0; j < 4; ++j) gg[j] = ldg4(g + 4 * (lane + 64 * j));
    for (int gi = gw; gi < NR / R; gi += ngw) {
        const int r0 = gi * R;
        f32x4 v[R][4]; const float* md[R];
#pragma unroll
        for (int q = 0; q < R; ++q) {
            const int r = r0 + q, b = r / LTOT, pp = r - b * LTOT;
            const float* xr;
            if (pp < LCTX) { xr = ctx + ((size_t)b * LCTX + pp) * DM; md[q] = mod + 8 * NMOD; }
            else { xr = lat + ((size_t)b * LSEQ + (pp - LCTX)) * DM; md[q] = mod + b * NMOD; }
#pragma unroll
            for (int j = 0; j < 4; ++j) v[q][j] = __builtin_nontemporal_load((const f32x4*)xr + lane + 64 * j);
        }
        f32x4 sh[R][4], sc[R][4];
#pragma unroll
        for (int q = 0; q < R; ++q)
#pragma unroll
            for (int j = 0; j < 4; ++j) { const int col = 4 * (lane + 64 * j); sh[q][j] = ldg4(md[q] + shoff + col); sc[q][j] = ldg4(md[q] + scoff + col); }
#pragma unroll
        for (int q = 0; q < R; ++q) {
            float ss = 0.f;
#pragma unroll
            for (int j = 0; j < 4; ++j) ss += (v[q][j].x * v[q][j].x + v[q][j].y * v[q][j].y) + (v[q][j].z * v[q][j].z + v[q][j].w * v[q][j].w);
            ss = wave_sum(ss);
            const float rstd = 1.0f / sqrtf(ss * (1.0f / DM) + EPS);
#pragma unroll
            for (int j = 0; j < 4; ++j) {
                const int col = 4 * (lane + 64 * j);
                const f32x4 y = (v[q][j] * rstd) * gg[j] * (sc[q][j] + 1.0f) + sh[q][j];
                u32x2 w; w.x = pk2(y.x, y.y); w.y = pk2(y.z, y.w);
                *(u32x2*)(H + (size_t)(r0 + q) * DM + col) = w;
            }
        }
    }
}

__device__ __forceinline__ void phase_prep1(const Params& p, int layer, int gw, int ngw, int lane) {
    constexpr int R = 2;
    unsigned char* ws = p.ws;
    const bf16_t* U = (const bf16_t*)(ws + OFF_U);
    bf16_t* Qg = (bf16_t*)(ws + OFF_QG); bf16_t* Kg = (bf16_t*)(ws + OFF_KG); bf16_t* Vg = (bf16_t*)(ws + OFF_VTG);
    bf16_t* CQn = (bf16_t*)(ws + OFF_CQN); bf16_t* CKVn = (bf16_t*)(ws + OFF_CKVN); bf16_t* KR = (bf16_t*)(ws + OFF_KR); bf16_t* Y = (bf16_t*)(ws + OFF_Y);
    const float* tabg = (const float*)(ws + OFF_ROPEG);
    const int ch = (lane + 16) & 63;
    float g1[8], g2[8];
    {
        const float* gv = ((lane < 48) ? p.g_q_gqa : p.g_k_gqa) + layer * 64 + 8 * (lane & 7);
        const f32x4 a = ldg4(gv), b = ldg4(gv + 4);
        g1[0] = a.x; g1[1] = a.y; g1[2] = a.z; g1[3] = a.w; g1[4] = b.x; g1[5] = b.y; g1[6] = b.z; g1[7] = b.w;
        const float* gw2 = (ch < 16) ? (p.g_cq + layer * 256) : (ch < 48) ? (p.g_cq + layer * 256 + 8 * (ch - 16)) : (p.g_ckv + layer * 128 + 8 * (ch - 48));
        const f32x4 c = ldg4(gw2), d = ldg4(gw2 + 4);
        g2[0] = c.x; g2[1] = c.y; g2[2] = c.z; g2[3] = c.w; g2[4] = d.x; g2[5] = d.y; g2[6] = d.z; g2[7] = d.w;
    }
    const int gi_ = lane >> 4, half = 1 << gi_;
    for (int gidx = gw; gidx < NR / R; gidx += ngw) {
        const int r0 = gidx * R;
        u32x4 w1[R], w2[R], wk[R]; u32x2 wp[R], nb[R][16]; f32x4 rc[R][2], rs[R][2];
        bool isctx[R]; int lo[R], hi[R];
#pragma unroll
        for (int q = 0; q < R; ++q) {
            const int r = r0 + q, b = r / LTOT, pp = r - b * LTOT;
            isctx[q] = pp < LCTX; const int t = isctx[q] ? 0 : pp - LCTX;
            const bf16_t* u = U + (size_t)r * UW;
            w1[q] = __builtin_nontemporal_load((const u32x4*)(u + 8 * lane));
            w2[q] = __builtin_nontemporal_load((const u32x4*)(u + 512 + 8 * ch));
            wk[q] = *(const u32x4*)(u + 1024 + 8 * (lane & 3));
            wp[q] = *(const u32x2*)(u + 1056 + 4 * lane);
            const int tt = isctx[q] ? pp : t, len = isctx[q] ? LCTX : LSEQ;
            lo[q] = max(tt - half, 0); hi[q] = min(tt + half, len);
#pragma unroll
            for (int jj = 0; jj < 16; ++jj) {
                const int j = tt + jj - 8;
                nb[q][jj] = (u32x2){0u, 0u};
                if (j >= lo[q] && j < hi[q]) nb[q][jj] = *(const u32x2*)(u + (ptrdiff_t)(jj - 8) * UW + 1056 + 4 * lane);
            }
            const float* tb = tabg + (size_t)t * 64 + 8 * (lane & 3);
            rc[q][0] = ldg4(tb); rc[q][1] = ldg4(tb + 4); rs[q][0] = ldg4(tb + 32); rs[q][1] = ldg4(tb + 36);
        }
#pragma unroll
        for (int q = 0; q < R; ++q) {
            const int r = r0 + q;
            {
                float v[8]; unpack8(w1[q], v);
                float ss = 0.f;
#pragma unroll
                for (int i = 0; i < 8; ++i) ss += v[i] * v[i];
                ss += swz_xor<1>(ss); ss += swz_xor<2>(ss); ss += swz_xor<4>(ss);
                const float rstd = 1.0f / sqrtf(ss * (1.0f / 64.0f) + EPS);
#pragma unroll
                for (int i = 0; i < 8; ++i) v[i] = v[i] * rstd * g1[i];
                const float cs[8] = {rc[q][0].x, rc[q][0].y, rc[q][0].z, rc[q][0].w, rc[q][1].x, rc[q][1].y, rc[q][1].z, rc[q][1].w};
                const float sn[8] = {rs[q][0].x, rs[q][0].y, rs[q][0].z, rs[q][0].w, rs[q][1].x, rs[q][1].y, rs[q][1].z, rs[q][1].w};
                float o[8];
#pragma unroll
                for (int i = 0; i < 8; ++i) {
                    const float pr = swz_xor<4>(v[i]);
                    if (isctx[q]) o[i] = v[i];
                    else o[i] = ((lane & 7) < 4) ? (v[i] * cs[i] - pr * sn[i]) : (pr * sn[i] + v[i] * cs[i]);
                }
                if (lane < 48) {
#pragma unroll
                    for (int i = 0; i < 8; ++i) o[i] *= QSCALE_G;
                    *(u32x4*)(Qg + (size_t)r * 384 + 8 * lane) = pack8(o);
                } else *(u32x4*)(Kg + (size_t)r * 128 + 8 * (lane - 48)) = pack8(o);
            }
            {
                float v[8]; unpack8(w2[q], v);
                float ss = 0.f;
#pragma unroll
                for (int i = 0; i < 8; ++i) ss += v[i] * v[i];
                ss += swz_xor<1>(ss); ss += swz_xor<2>(ss); ss += swz_xor<4>(ss); ss += swz_xor<8>(ss);
                const float ss2 = ss + swz_xor<16>(ss);
                if (ch < 16) {
                    *(u32x4*)(Vg + (size_t)r * 128 + 8 * ch) = w2[q];
                } else if (ch < 48) {
                    const float rstd = 1.0f / sqrtf(ss2 * (1.0f / 256.0f) + EPS);
#pragma unroll
                    for (int i = 0; i < 8; ++i) v[i] = v[i] * rstd * g2[i];
                    *(u32x4*)(CQn + (size_t)r * 256 + 8 * (ch - 16)) = pack8(v);
                } else {
                    const float rstd = 1.0f / sqrtf(ss * (1.0f / 128.0f) + EPS);
#pragma unroll
                    for (int i = 0; i < 8; ++i) v[i] = v[i] * rstd * g2[i];
                    *(u32x4*)(CKVn + (size_t)r * 128 + 8 * (ch - 48)) = pack8(v);
                }
            }
            if (lane < 4) *(u32x4*)(KR + (size_t)r * 32 + 8 * lane) = wk[q];
            {
                float v[4]; unpack4(wp[q], v);
                float s[4] = {0.f, 0.f, 0.f, 0.f};
#pragma unroll
                for (int jj = 0; jj < 16; ++jj) { float nv[4]; unpack4(nb[q][jj], nv);
#pragma unroll
                    for (int i = 0; i < 4; ++i) s[i] += nv[i]; }
                const float inv = 1.0f / (float)(hi[q] - lo[q]);
                u32x2 w; w.x = pk2(s[0] * inv - v[0], s[1] * inv - v[1]); w.y = pk2(s[2] * inv - v[2], s[3] * inv - v[3]);
                *(u32x2*)(Y + (size_t)r * 256 + 4 * lane) = w;
            }
        }
    }
}

__device__ __forceinline__ void phase_prep2(const Params& p, int layer, int gw, int ngw, int lane) {
    constexpr int R = 3;
    unsigned char* ws = p.ws;
    const bf16_t* QMraw = (const bf16_t*)(ws + OFF_QMRAW); const bf16_t* KVraw = (const bf16_t*)(ws + OFF_KVRAW); const bf16_t* KR = (const bf16_t*)(ws + OFF_KR);
    bf16_t* Qm = (bf16_t*)(ws + OFF_QM); bf16_t* Km = (bf16_t*)(ws + OFF_KM);
    const float* tabm = (const float*)(ws + OFF_ROPEM);
    const int h = (lane < 48) ? (lane >> 3) : 5, j8 = lane & 7; const bool act = lane < 48;
    float gn[2][8], gr[2][4];
#pragma unroll
    for (int which = 0; which < 2; ++which) {
        const float* gv = (which == 0 ? p.g_q_mla : p.g_k_mla) + layer * 96;
        const f32x4 a = ldg4(gv + 8 * j8), b = ldg4(gv + 8 * j8 + 4), c = ldg4(gv + 64 + 4 * j8);
        gn[which][0] = a.x; gn[which][1] = a.y; gn[which][2] = a.z; gn[which][3] = a.w; gn[which][4] = b.x; gn[which][5] = b.y; gn[which][6] = b.z; gn[which][7] = b.w;
        gr[which][0] = c.x; gr[which][1] = c.y; gr[which][2] = c.z; gr[which][3] = c.w;
    }
    for (int gidx = gw; gidx < NR / R; gidx += ngw) {
        const int r0 = gidx * R;
        u32x4 wn[R][2]; u32x2 wr[R][2]; f32x4 rc[R], rs[R]; bool isctx[R];
#pragma unroll
        for (int q = 0; q < R; ++q) {
            const int r = r0 + q, b = r / LTOT, pp = r - b * LTOT;
            isctx[q] = pp < LCTX; const int t = isctx[q] ? 0 : pp - LCTX;
            wn[q][0] = __builtin_nontemporal_load((const u32x4*)(QMraw + (size_t)r * 768 + h * 96 + 8 * j8)); wr[q][0] = __builtin_nontemporal_load((const u32x2*)(QMraw + (size_t)r * 768 + h * 96 + 64 + 4 * j8));
            wn[q][1] = __builtin_nontemporal_load((const u32x4*)(KVraw + (size_t)r * 768 + h * 128 + 8 * j8)); wr[q][1] = *(const u32x2*)(KR + (size_t)r * 32 + 4 * j8);
            const float* tb = tabm + (size_t)t * 32 + 4 * (j8 & 3);
            rc[q] = ldg4(tb); rs[q] = ldg4(tb + 16);
        }
#pragma unroll
        for (int q = 0; q < R; ++q) {
            const int r = r0 + q;
            const float cs[4] = {rc[q].x, rc[q].y, rc[q].z, rc[q].w}, sn[4] = {rs[q].x, rs[q].y, rs[q].z, rs[q].w};
#pragma unroll
            for (int which = 0; which < 2; ++which) {
                float vn[8], vr[4]; unpack8(wn[q][which], vn); unpack4(wr[q][which], vr);
                float ss = 0.f;
#pragma unroll
                for (int i = 0; i < 8; ++i) ss += vn[i] * vn[i];
#pragma unroll
                for (int i = 0; i < 4; ++i) ss += vr[i] * vr[i];
                ss += swz_xor<1>(ss); ss += swz_xor<2>(ss); ss += swz_xor<4>(ss);
                const float rstd = 1.0f / sqrtf(ss * (1.0f / 96.0f) + EPS);
                const float qs = which == 0 ? QSCALE_M : 1.0f;
#pragma unroll
                for (int i = 0; i < 8; ++i) vn[i] = vn[i] * rstd * gn[which][i] * qs;
#pragma unroll
                for (int i = 0; i < 4; ++i) vr[i] = vr[i] * rstd * gr[which][i];
                float o[4];
#pragma unroll
                for (int i = 0; i < 4; ++i) {
                    const float pr = swz_xor<4>(vr[i]);
                    if (isctx[q]) o[i] = vr[i];
                    else o[i] = (j8 < 4) ? (vr[i] * cs[i] - pr * sn[i]) : (pr * sn[i] + vr[i] * cs[i]);
                    o[i] *= qs;
                }
                if (act) {
                    bf16_t* dst = (which == 0 ? Qm : Km) + (size_t)r * 576 + h * 96;
                    *(u32x4*)(dst + 8 * j8) = pack8(vn);
                    u32x2 w; w.x = pk2(o[0], o[1]); w.y = pk2(o[2], o[3]);
                    *(u32x2*)(dst + 64 + 4 * j8) = w;
                }
            }
        }
    }
}

typedef short s16x4 __attribute__((ext_vector_type(4)));
__device__ __forceinline__ s16x4 vtr(LAS unsigned char* p) { return __builtin_bit_cast(s16x4, __builtin_amdgcn_ds_read_tr16_b64_v4i16((LAS s16x4*)p)); }
constexpr float ATT_BMAX = 56.0f;
template <int DK> struct AttnCtx {
    static constexpr int KSTR = DK * 2 + 16, VSTR = 192, NDS = DK / 16, KCH = DK / 8, KBUF = 64 * 208, VBUF = 64 * 192;
};
template <int DK, int PAR, bool HASNEXT, bool LDK, bool LDV, bool STK>
__device__ __forceinline__ void attn_step(LAS unsigned char* lds, f32x16& C0, f32x16& C1, f32x16& N0, f32x16& N1, f32x16& o0, f32x16& o1, float& l,
                                          const bf16x8 (&qf)[DK / 16], const bf16_t* kg0, const bf16_t* kg1, const bf16_t* vg, size_t kstep, size_t vstep, int t,
                                          bool has1, int kl0, int kl1, int vl, int aoffk, int aoffv,
                                          u32x4& ldk0, u32x4& ldk1, u32x4& ldv, const u32x4& stk0, const u32x4& stk1, const u32x4& stv) {
    using A = AttnCtx<DK>;
    LAS unsigned char* Kb = lds + ((PAR ^ 1) * A::KBUF);
    LAS unsigned char* Vb = lds + 2 * A::KBUF + PAR * A::VBUF;
    __builtin_amdgcn_s_setprio(1);
    if (LDK) { ldk0 = *(const u32x4*)(kg0 + (size_t)(t + 3) * kstep); if (has1) ldk1 = *(const u32x4*)(kg1 + (size_t)(t + 3) * kstep); }
    if (LDV) ldv = *(const u32x4*)(vg + (size_t)(t + 2) * vstep);
    bf16x8 kf[A::NDS][2];
    if (HASNEXT) {
#pragma unroll
        for (int ds = 0; ds < A::NDS; ++ds) {
            kf[ds][0] = *(const LAS bf16x8*)(Kb + aoffk + ds * 32);
            kf[ds][1] = *(const LAS bf16x8*)(Kb + aoffk + 32 * A::KSTR + ds * 32);
        }
    }
    s16x4 vlo[4][2], vhi[4][2];
#pragma unroll
    for (int j = 0; j < 2; ++j) {
        vlo[j][0] = vtr(Vb + aoffv + j * 16 * A::VSTR); vhi[j][0] = vtr(Vb + aoffv + (j * 16 + 8) * A::VSTR);
        vlo[j][1] = vtr(Vb + aoffv + j * 16 * A::VSTR + 64); vhi[j][1] = vtr(Vb + aoffv + (j * 16 + 8) * A::VSTR + 64);
    }
    if (HASNEXT) {
        f32x16 z;
#pragma unroll
        for (int i = 0; i < 16; ++i) z[i] = 0.f;
#pragma unroll
        for (int ds = 0; ds < A::NDS; ++ds) {
            N0 = __builtin_amdgcn_mfma_f32_32x32x16_bf16(kf[ds][0], qf[ds], ds == 0 ? z : N0, 0, 0, 0);
            N1 = __builtin_amdgcn_mfma_f32_32x32x16_bf16(kf[ds][1], qf[ds], ds == 0 ? z : N1, 0, 0, 0);
        }
    }
#pragma unroll
    for (int i = 0; i < 16; ++i) { l += C0[i]; l += C1[i]; }
    bf16x8 pb[4];
    { u32x4 w;
      w.x = pk2(C0[0], C0[1]); w.y = pk2(C0[2], C0[3]); w.z = pk2(C0[4], C0[5]); w.w = pk2(C0[6], C0[7]); pb[0] = __builtin_bit_cast(bf16x8, w);
      w.x = pk2(C0[8], C0[9]); w.y = pk2(C0[10], C0[11]); w.z = pk2(C0[12], C0[13]); w.w = pk2(C0[14], C0[15]); pb[1] = __builtin_bit_cast(bf16x8, w);
      w.x = pk2(C1[0], C1[1]); w.y = pk2(C1[2], C1[3]); w.z = pk2(C1[4], C1[5]); w.w = pk2(C1[6], C1[7]); pb[2] = __builtin_bit_cast(bf16x8, w);
      w.x = pk2(C1[8], C1[9]); w.y = pk2(C1[10], C1[11]); w.z = pk2(C1[12], C1[13]); w.w = pk2(C1[14], C1[15]); pb[3] = __builtin_bit_cast(bf16x8, w); }
    if (HASNEXT) {
        constexpr int VPER = (DK == 64) ? 6 : 4;
#pragma unroll
        for (int g = 0; g < 2 * A::NDS; ++g) { __builtin_amdgcn_sched_group_barrier(0x008, 1, 0); __builtin_amdgcn_sched_group_barrier(0x002, VPER, 0); }
    }
    asm volatile("" : "+v"(l));
    __builtin_amdgcn_sched_barrier(0);
#pragma unroll
    for (int j = 2; j < 4; ++j) {
        vlo[j][0] = vtr(Vb + aoffv + j * 16 * A::VSTR); vhi[j][0] = vtr(Vb + aoffv + (j * 16 + 8) * A::VSTR);
        vlo[j][1] = vtr(Vb + aoffv + j * 16 * A::VSTR + 64); vhi[j][1] = vtr(Vb + aoffv + (j * 16 + 8) * A::VSTR + 64);
    }
#pragma unroll
    for (int j = 0; j < 4; ++j) {
        const bf16x8 a0 = __builtin_shufflevector(vlo[j][0], vhi[j][0], 0, 1, 2, 3, 4, 5, 6, 7);
        const bf16x8 a1 = __builtin_shufflevector(vlo[j][1], vhi[j][1], 0, 1, 2, 3, 4, 5, 6, 7);
        o0 = __builtin_amdgcn_mfma_f32_32x32x16_bf16(a0, pb[j], o0, 0, 0, 0);
        o1 = __builtin_amdgcn_mfma_f32_32x32x16_bf16(a1, pb[j], o1, 0, 0, 0);
    }
    if (HASNEXT) {
#pragma unroll
        for (int i = 0; i < 16; ++i) { N0[i] = __builtin_amdgcn_exp2f(N0[i]); N1[i] = __builtin_amdgcn_exp2f(N1[i]); }
#pragma unroll
        for (int g = 0; g < 8; ++g) { __builtin_amdgcn_sched_group_barrier(0x008, 1, 0); __builtin_amdgcn_sched_group_barrier(0x002, 4, 0); }
    }
    __builtin_amdgcn_sched_barrier(0);
    __builtin_amdgcn_s_setprio(0);
    if (STK) { LAS unsigned char* Kn = lds + PAR * A::KBUF; *(LAS u32x4*)(Kn + kl0) = stk0; if (has1) *(LAS u32x4*)(Kn + kl1) = stk1; }
    if (HASNEXT) { LAS unsigned char* Vn = lds + 2 * A::KBUF + (PAR ^ 1) * A::VBUF; *(LAS u32x4*)(Vn + vl) = stv; }
    asm volatile("s_waitcnt lgkmcnt(0)\n\ts_barrier" ::: "memory");
}

template <int DK>
__device__ __forceinline__ void attn_unit(LAS unsigned char* lds, const bf16_t* Qp, int qpitch, const bf16_t* Kp, int kpitch, const bf16_t* Vp, int vpitch, bf16_t* Op, int nt) {
    using A = AttnCtx<DK>;
    constexpr int KSTR = A::KSTR, VSTR = A::VSTR, NDS = A::NDS, KCH = A::KCH, KBUF = A::KBUF;
    int tid_ = threadIdx.x; asm volatile("" : "+v"(tid_));
    const int tid = tid_, lane = tid & 63, wid = tid >> 6, r32 = lane & 31, hi = lane >> 5;
    bf16x8 qf[NDS];
    {
        const bf16_t* qrow = Qp + (size_t)(wid * 32 + r32) * qpitch + 8 * hi;
#pragma unroll
        for (int ds = 0; ds < NDS; ++ds) qf[ds] = *(const bf16x8*)(qrow + ds * 16);
    }
    const int kr0 = tid / KCH, kc0 = tid % KCH;
    const int c1 = tid + NTHREADS; const bool has1 = (DK == 96) && (c1 < 64 * KCH);
    const int kr1 = has1 ? c1 / KCH : 0, kc1 = has1 ? c1 % KCH : 0;
    const int vd = tid >> 3, vc = tid & 7;
    const bf16_t* kg0 = Kp + (size_t)kr0 * kpitch + kc0 * 8;
    const bf16_t* kg1 = Kp + (size_t)kr1 * kpitch + kc1 * 8;
    const bf16_t* vg = Vp + (size_t)vd * vpitch + vc * 8;
    const size_t kstep = (size_t)64 * kpitch, vstep = (size_t)64 * vpitch;
    const int kl0 = kr0 * KSTR + kc0 * 16, kl1 = kr1 * KSTR + kc1 * 16, vl = vd * VSTR + vc * 16;
    const int aoffk = r32 * KSTR + hi * 16;
    const int aoffv = (4 * hi + ((lane & 15) >> 2)) * VSTR + (((lane >> 4) & 1) * 16 + (lane & 3) * 4) * 2;
    {
        const u32x4 a0 = *(const u32x4*)kg0, b0 = *(const u32x4*)(kg0 + kstep), v0 = *(const u32x4*)vg;
        u32x4 a1 = {0u, 0u, 0u, 0u}, b1 = {0u, 0u, 0u, 0u};
        if (has1) { a1 = *(const u32x4*)kg1; b1 = *(const u32x4*)(kg1 + kstep); }
        *(LAS u32x4*)(lds + kl0) = a0; *(LAS u32x4*)(lds + KBUF + kl0) = b0; *(LAS u32x4*)(lds + 2 * KBUF + vl) = v0;
        if (has1) { *(LAS u32x4*)(lds + kl1) = a1; *(LAS u32x4*)(lds + KBUF + kl1) = b1; }
    }
    u32x4 rkA0 = {0u, 0u, 0u, 0u}, rkA1 = {0u, 0u, 0u, 0u}, rvA = {0u, 0u, 0u, 0u}, rkB0, rkB1 = {0u, 0u, 0u, 0u}, rvB;
    rkB0 = *(const u32x4*)(kg0 + 2 * kstep); if (has1) rkB1 = *(const u32x4*)(kg1 + 2 * kstep); rvB = *(const u32x4*)(vg + vstep);
    __syncthreads();
    f32x16 o0, o1, cA0, cA1, cB0, cB1;
#pragma unroll
    for (int i = 0; i < 16; ++i) { o0[i] = 0.f; o1[i] = 0.f; cA0[i] = 0.f; cA1[i] = 0.f; }
#pragma unroll
    for (int ds = 0; ds < NDS; ++ds) {
        const bf16x8 a0 = *(const LAS bf16x8*)(lds + aoffk + ds * 32);
        const bf16x8 a1 = *(const LAS bf16x8*)(lds + aoffk + 32 * KSTR + ds * 32);
        cA0 = __builtin_amdgcn_mfma_f32_32x32x16_bf16(a0, qf[ds], cA0, 0, 0, 0);
        cA1 = __builtin_amdgcn_mfma_f32_32x32x16_bf16(a1, qf[ds], cA1, 0, 0, 0);
    }
#pragma unroll
    for (int i = 0; i < 16; ++i) { cA0[i] = __builtin_amdgcn_exp2f(cA0[i]); cA1[i] = __builtin_amdgcn_exp2f(cA1[i]); }
    __syncthreads();
    float l = 0.f;
    int t = 0;
#define ATT_EVEN(c0_, c1_, n0_, n1_, tt_) lds, c0_, c1_, n0_, n1_, o0, o1, l, qf, kg0, kg1, vg, kstep, vstep, tt_, has1, kl0, kl1, vl, aoffk, aoffv, rkA0, rkA1, rvA, rkB0, rkB1, rvB
#define ATT_ODD(c0_, c1_, n0_, n1_, tt_) lds, c0_, c1_, n0_, n1_, o0, o1, l, qf, kg0, kg1, vg, kstep, vstep, tt_, has1, kl0, kl1, vl, aoffk, aoffv, rkB0, rkB1, rvB, rkA0, rkA1, rvA
    for (; t + 4 < nt; t += 2) {
        attn_step<DK, 0, true, true, true, true>(ATT_EVEN(cA0, cA1, cB0, cB1, t));
        attn_step<DK, 1, true, true, true, true>(ATT_ODD(cB0, cB1, cA0, cA1, t + 1));
    }
    attn_step<DK, 0, true, true, true, true>(ATT_EVEN(cA0, cA1, cB0, cB1, t));
    attn_step<DK, 1, true, false, true, true>(ATT_ODD(cB0, cB1, cA0, cA1, t + 1));
    attn_step<DK, 0, true, false, false, false>(ATT_EVEN(cA0, cA1, cB0, cB1, t + 2));
    attn_step<DK, 1, false, false, false, false>(ATT_ODD(cB0, cB1, cA0, cA1, t + 3));
#undef ATT_EVEN
#undef ATT_ODD
    l = xhalf_add(l);
    const float inv = 1.0f / l;
    bf16_t* orow = Op + (size_t)(wid * 32 + r32) * 1024 + 8 * hi;
#pragma unroll
    for (int db = 0; db < 2; ++db)
#pragma unroll
        for (int k = 0; k < 2; ++k) {
            const f32x16& oo = db == 0 ? o0 : o1;
            const unsigned ax = pk2(oo[8 * k] * inv, oo[8 * k + 1] * inv), ay = pk2(oo[8 * k + 2] * inv, oo[8 * k + 3] * inv);
            const unsigned bx = pk2(oo[8 * k + 4] * inv, oo[8 * k + 5] * inv), by = pk2(oo[8 * k + 6] * inv, oo[8 * k + 7] * inv);
            const auto sx = __builtin_amdgcn_permlane32_swap(ax, bx, false, false), sy = __builtin_amdgcn_permlane32_swap(ay, by, false, false);
            u32x4 w; w.x = sx[0]; w.y = sy[0]; w.z = sx[1]; w.w = sy[1];
            *(u32x4*)(orow + db * 32 + 16 * k) = w;
        }
}

template <int DK>
__device__ __forceinline__ void attn_unit_safe(LAS unsigned char* lds, const bf16_t* Qp, int qpitch, const bf16_t* Kp, int kpitch, const bf16_t* Vp, int vpitch, bf16_t* Op, int nt) {
    constexpr int KSTR = DK * 2 + 16, VSTR = 192, NDS = DK / 16, KCH = DK / 8;
    constexpr int KBUF = 64 * 208, VBUF = 64 * 192;
    int tid_ = threadIdx.x; asm volatile("" : "+v"(tid_));
    const int tid = tid_, lane = tid & 63, wid = tid >> 6, r32 = lane & 31, hi = lane >> 5;
    LAS unsigned char* Kb0 = lds; LAS unsigned char* Vb0 = lds + 2 * KBUF;
    bf16x8 qf[NDS];
    {
        const bf16_t* qrow = Qp + (size_t)(wid * 32 + r32) * qpitch + 8 * hi;
#pragma unroll
        for (int ds = 0; ds < NDS; ++ds) qf[ds] = *(const bf16x8*)(qrow + ds * 16);
    }
    const int kr0 = tid / KCH, kc0 = tid % KCH;
    const int c1 = tid + NTHREADS; const bool has1 = (DK == 96) && (c1 < 64 * KCH);
    const int kr1 = has1 ? c1 / KCH : 0, kc1 = has1 ? c1 % KCH : 0;
    const int vd = tid >> 3, vc = tid & 7;
    const bf16_t* kg0 = Kp + (size_t)kr0 * kpitch + kc0 * 8;
    const bf16_t* kg1 = Kp + (size_t)kr1 * kpitch + kc1 * 8;
    const bf16_t* vg = Vp + (size_t)vd * vpitch + vc * 8;
    const int kl0 = kr0 * KSTR + kc0 * 16, kl1 = kr1 * KSTR + kc1 * 16, vl = vd * VSTR + vc * 16;
    u32x4 rk0, rk1 = {0u, 0u, 0u, 0u}, rv;
    rk0 = *(const u32x4*)kg0; if (has1) rk1 = *(const u32x4*)kg1; rv = *(const u32x4*)vg;
    *(LAS u32x4*)(Kb0 + kl0) = rk0; if (has1) *(LAS u32x4*)(Kb0 + kl1) = rk1; *(LAS u32x4*)(Vb0 + vl) = rv;
    __syncthreads();
    f32x16 o0, o1;
#pragma unroll
    for (int i = 0; i < 16; ++i) { o0[i] = 0.f; o1[i] = 0.f; }
    float m = -1e30f, l = 0.f;
    const int aoffk = r32 * KSTR + hi * 16;
    const int aoffv = (4 * hi + ((lane & 15) >> 2)) * VSTR + (((lane >> 4) & 1) * 16 + (lane & 3) * 4) * 2;
    for (int kt = 0; kt < nt; ++kt) {
        const int cur = kt & 1;
        LAS unsigned char* Kb = Kb0 + cur * KBUF; LAS unsigned char* Vb = Vb0 + cur * VBUF;
        const bool more = kt + 1 < nt;
        if (more) {
            const size_t ko = (size_t)(kt + 1) * 64 * kpitch;
            rk0 = *(const u32x4*)(kg0 + ko); if (has1) rk1 = *(const u32x4*)(kg1 + ko); rv = *(const u32x4*)(vg + (size_t)(kt + 1) * 64 * vpitch);
        }
        f32x16 s0, s1;
#pragma unroll
        for (int i = 0; i < 16; ++i) { s0[i] = 0.f; s1[i] = 0.f; }
#pragma unroll
        for (int ds = 0; ds < NDS; ++ds) {
            const bf16x8 a0 = *(const LAS bf16x8*)(Kb + aoffk + ds * 32);
            const bf16x8 a1 = *(const LAS bf16x8*)(Kb + aoffk + 32 * KSTR + ds * 32);
            s0 = __builtin_amdgcn_mfma_f32_32x32x16_bf16(a0, qf[ds], s0, 0, 0, 0);
            s1 = __builtin_amdgcn_mfma_f32_32x32x16_bf16(a1, qf[ds], s1, 0, 0, 0);
        }
        float mx = fmaxf(s0[0], s1[0]);
#pragma unroll
        for (int i = 1; i < 16; ++i) mx = fmaxf(mx, fmaxf(s0[i], s1[i]));
        mx = xhalf_max(mx);
        const float mnew = fmaxf(m, mx);
        const float alpha = __builtin_amdgcn_exp2f(m - mnew);
        m = mnew;
        float ps = 0.f;
#pragma unroll
        for (int i = 0; i < 16; ++i) { s0[i] = __builtin_amdgcn_exp2f(s0[i] - mnew); s1[i] = __builtin_amdgcn_exp2f(s1[i] - mnew); ps += s0[i] + s1[i]; }
        l = l * alpha + ps;
#pragma unroll
        for (int i = 0; i < 16; ++i) { o0[i] *= alpha; o1[i] *= alpha; }
        bf16x8 pb[4];
        { u32x4 w;
          w.x = pk2(s0[0], s0[1]); w.y = pk2(s0[2], s0[3]); w.z = pk2(s0[4], s0[5]); w.w = pk2(s0[6], s0[7]); pb[0] = __builtin_bit_cast(bf16x8, w);
          w.x = pk2(s0[8], s0[9]); w.y = pk2(s0[10], s0[11]); w.z = pk2(s0[12], s0[13]); w.w = pk2(s0[14], s0[15]); pb[1] = __builtin_bit_cast(bf16x8, w);
          w.x = pk2(s1[0], s1[1]); w.y = pk2(s1[2], s1[3]); w.z = pk2(s1[4], s1[5]); w.w = pk2(s1[6], s1[7]); pb[2] = __builtin_bit_cast(bf16x8, w);
          w.x = pk2(s1[8], s1[9]); w.y = pk2(s1[10], s1[11]); w.z = pk2(s1[12], s1[13]); w.w = pk2(s1[14], s1[15]); pb[3] = __builtin_bit_cast(bf16x8, w); }
#pragma unroll
        for (int j = 0; j < 4; ++j) {
            const s16x4 l0 = vtr(Vb + aoffv + j * 16 * VSTR), h0 = vtr(Vb + aoffv + (j * 16 + 8) * VSTR);
            const s16x4 l1 = vtr(Vb + aoffv + j * 16 * VSTR + 64), h1 = vtr(Vb + aoffv + (j * 16 + 8) * VSTR + 64);
            const bf16x8 a0 = __builtin_shufflevector(l0, h0, 0, 1, 2, 3, 4, 5, 6, 7);
            const bf16x8 a1 = __builtin_shufflevector(l1, h1, 0, 1, 2, 3, 4, 5, 6, 7);
            o0 = __builtin_amdgcn_mfma_f32_32x32x16_bf16(a0, pb[j], o0, 0, 0, 0);
            o1 = __builtin_amdgcn_mfma_f32_32x32x16_bf16(a1, pb[j], o1, 0, 0, 0);
        }
        if (more) {
            LAS unsigned char* Kn = Kb0 + (cur ^ 1) * KBUF; LAS unsigned char* Vn = Vb0 + (cur ^ 1) * VBUF;
            *(LAS u32x4*)(Kn + kl0) = rk0; if (has1) *(LAS u32x4*)(Kn + kl1) = rk1; *(LAS u32x4*)(Vn + vl) = rv;
        }
        __syncthreads();
    }
    l = xhalf_add(l);
    const float inv = 1.0f / l;
    bf16_t* orow = Op + (size_t)(wid * 32 + r32) * 1024 + 4 * hi;
#pragma unroll
    for (int g = 0; g < 4; ++g) {
        u32x2 w; w.x = pk2(o0[4 * g] * inv, o0[4 * g + 1] * inv); w.y = pk2(o0[4 * g + 2] * inv, o0[4 * g + 3] * inv);
        *(u32x2*)(orow + 8 * g) = w;
        w.x = pk2(o1[4 * g] * inv, o1[4 * g + 1] * inv); w.y = pk2(o1[4 * g + 2] * inv, o1[4 * g + 3] * inv);
        *(u32x2*)(orow + 32 + 8 * g) = w;
    }
}

__device__ __forceinline__ void attn_dispatch(const Params& p, LAS unsigned char* lds, int b, int head, int qrow0, int nt, bool fastg, bool fastm) {
    unsigned char* ws = p.ws;
    const size_t rb = (size_t)b * LTOT;
    bf16_t* MIX = (bf16_t*)(ws + OFF_MIX);
    if (head < 6) {
        const int kvh = head / 3;
        const bf16_t* Qp = (const bf16_t*)(ws + OFF_QG) + (rb + qrow0) * 384 + head * 64; const bf16_t* Kp = (const bf16_t*)(ws + OFF_KG) + rb * 128 + kvh * 64;
        const bf16_t* Vp = (const bf16_t*)(ws + OFF_VTG) + rb * 128 + kvh * 64; bf16_t* Op = MIX + (rb + qrow0) * 1024 + head * 64;
        if (fastg) attn_unit<64>(lds, Qp, 384, Kp, 128, Vp, 128, Op, nt); else attn_unit_safe<64>(lds, Qp, 384, Kp, 128, Vp, 128, Op, nt);
    } else {
        const int hm = head - 6;
        const bf16_t* Qp = (const bf16_t*)(ws + OFF_QM) + (rb + qrow0) * 576 + hm * 96; const bf16_t* Kp = (const bf16_t*)(ws + OFF_KM) + rb * 576 + hm * 96;
        const bf16_t* Vp = (const bf16_t*)(ws + OFF_KVRAW) + rb * 768 + hm * 128 + 64; bf16_t* Op = MIX + (rb + qrow0) * 1024 + 384 + hm * 64;
        if (fastm) attn_unit<96>(lds, Qp, 576, Kp, 576, Vp, 768, Op, nt); else attn_unit_safe<96>(lds, Qp, 576, Kp, 576, Vp, 768, Op, nt);
    }
}

__device__ __forceinline__ float absmax_vec(const float* g, int n) { float m = 0.f; for (int i = 0; i < n; ++i) m = fmaxf(m, fabsf(g[i])); return m; }

__device__ __forceinline__ void phase_attn(const Params& p, LAS unsigned char* lds, int G, bool do_ctx, int layer) {
    const float bg = 8.0f * absmax_vec(p.g_q_gqa + layer * 64, 64) * absmax_vec(p.g_k_gqa + layer * 64, 64) * LOG2E * 1.05f;
    const float bm = 9.797959f * absmax_vec(p.g_q_mla + layer * 96, 96) * absmax_vec(p.g_k_mla + layer * 96, 96) * LOG2E * 1.05f;
    const bool fastg = bg < ATT_BMAX, fastm = bm < ATT_BMAX;
    for (int uid = blockIdx.x; uid < 8 * 32 * 12; uid += G) {
        const int b = uid & 7, qb = (uid >> 3) & 31, head = uid >> 8;
        attn_dispatch(p, lds, b, head, LCTX + qb * 256, LTOT / 64, fastg, fastm);
    }
    if (do_ctx)
        for (int uid = blockIdx.x; uid < 8 * 12; uid += G) {
            const int b = uid & 7, head = uid >> 3;
            attn_dispatch(p, lds, b, head, 0, LCTX / 64, fastg, fastm);
        }
}

#define XB_TMO      128
#define XB_XCNT(j)  (256  + 64 * (j))
#define XB_XSUB(j)  (1280 + 64 * (j))
#define XB_XGEN(j)  (2304 + 64 * (j))
#define XB_TOP      3328
#define XB_TOPGEN   3392
#define XCD_BAR_WORDS 3456
#define XB_SPIN_CAP (1u << 18)

__device__ __forceinline__ unsigned xb_ld(unsigned* p)              { return __hip_atomic_load(p, __ATOMIC_RELAXED, __HIP_MEMORY_SCOPE_AGENT); }
__device__ __forceinline__ unsigned xb_add(unsigned* p, unsigned v) { return __hip_atomic_fetch_add(p, v, __ATOMIC_RELAXED, __HIP_MEMORY_SCOPE_AGENT); }
__device__ __forceinline__ unsigned xb_xcc_id() { return (unsigned)__builtin_amdgcn_s_getreg((3 << 11) | 20) & 0xFu; }
#define XB_SPIN(cond, bar) do { unsigned _sp = 0; while (cond) { __builtin_amdgcn_s_sleep(1); \
    if ((++_sp & 255u) == 0u) { if (xb_ld(&(bar)[XB_TMO])) break; if (_sp > XB_SPIN_CAP) { atomicAdd(&(bar)[XB_TMO], 1u); break; } } } } while (0)

struct XcdBarrier {
    unsigned* bar; unsigned x;
    volatile LAS unsigned* st;
};

__device__ __forceinline__ XcdBarrier xcd_barrier_post(unsigned* bar, volatile LAS unsigned* st) {
    XcdBarrier b; b.bar = bar; b.x = xb_xcc_id(); b.st = st;
    if (threadIdx.x == 0) (void)xb_add(&bar[XB_XCNT(b.x)], 1u);
    return b;
}
__device__ __forceinline__ void xcd_barrier_complete(unsigned* bar, unsigned x, unsigned& nloc, unsigned& nx) {
    const unsigned G = gridDim.x * gridDim.y * gridDim.z;
    unsigned sum, cnt, mine, sp = 0u;
    for (;;) {
        sum = 0u; cnt = 0u; mine = 0u;
#pragma unroll
        for (unsigned j = 0; j < 16; ++j) { const unsigned c = xb_ld(&bar[XB_XCNT(j)]); sum += c; cnt += (c > 0u) ? 1u : 0u; mine = (j == x) ? c : mine; }
        if (sum == G) break;
        __builtin_amdgcn_s_sleep(1);
        if ((++sp & 255u) == 0u) { if (xb_ld(&bar[XB_TMO])) break; if (sp > XB_SPIN_CAP) { atomicAdd(&bar[XB_TMO], 1u); break; } }
    }
    nloc = mine > 0u ? mine : 1u; nx = cnt > 0u ? cnt : 1u;
}

__device__ __forceinline__ void xcd_barrier(const XcdBarrier& b) {
    asm volatile("s_waitcnt vmcnt(0)" ::: "memory");
    __syncthreads();
    if (threadIdx.x == 0) {
        unsigned* bar = b.bar;
        __builtin_amdgcn_s_waitcnt(0);
        unsigned nloc = b.st[0], nx = b.st[1];
        if (nloc == 0u) { xcd_barrier_complete(bar, b.x, nloc, nx); b.st[0] = nloc; b.st[1] = nx; }
        const unsigned old = xb_add(&bar[XB_XSUB(b.x)], 1u);
        const unsigned gen = old / nloc;
        if (old + 1u == (gen + 1u) * nloc) {
            __builtin_amdgcn_fence(__ATOMIC_RELEASE, "agent");
            asm volatile("s_waitcnt vmcnt(0)" ::: "memory");
            const unsigned og = xb_add(&bar[XB_TOP], 1u);
            const unsigned tg = og / nx;
            if (og + 1u == (tg + 1u) * nx) xb_add(&bar[XB_TOPGEN], 1u);
            else XB_SPIN(xb_ld(&bar[XB_TOPGEN]) == tg, bar);
            __builtin_amdgcn_fence(__ATOMIC_ACQUIRE, "agent");
            xb_add(&bar[XB_XGEN(b.x)], 1u);
            asm volatile("s_waitcnt vmcnt(0)" ::: "memory");
        } else {
            XB_SPIN(xb_ld(&bar[XB_XGEN(b.x)]) == gen, bar);
            __builtin_amdgcn_fence(__ATOMIC_ACQUIRE, "agent");
            asm volatile("s_waitcnt vmcnt(0)" ::: "memory");
        }
    }
    __syncthreads();
}

__global__ void __launch_bounds__(NTHREADS, 2) mega_fwd(Params p) {
    extern __shared__ __attribute__((aligned(16))) unsigned char lds_raw[];
    LAS unsigned char* lds = (LAS unsigned char*)lds_raw;
    cg::grid_group grid = cg::this_grid();
    const int G = gridDim.x;
    const int ngw = G * NWAVES;
#define FRESH_IDS() int tid = threadIdx.x; asm volatile("" : "+v"(tid)); const int lane = tid & 63, gw = blockIdx.x * NWAVES + (tid >> 6)
    unsigned char* ws = p.ws;
    float* xctx = (float*)(ws + OFF_XCTX);
    const float* modall = (const float*)(ws + OFF_MOD);
    bf16_t* H = (bf16_t*)(ws + OFF_H);

#ifndef NO_PRO
    if (threadIdx.x < 2) ((LAS unsigned*)(lds + 131072))[threadIdx.x] = 0u;
    __syncthreads();
    (void)xcd_barrier_post((unsigned*)(ws + OFF_BAR), (volatile LAS unsigned*)(lds + 131072));
#define GSYNC() do { XcdBarrier b_; b_.bar = (unsigned*)(p.ws + OFF_BAR); b_.x = xb_xcc_id(); b_.st = (volatile LAS unsigned*)(lds + 131072); xcd_barrier(b_); } while (0)
    phase_prologue(p, lds, G);
#endif
    if (p.ws == nullptr) grid.sync();
    GSYNC();
    phase_modfinal(p, G);
    GSYNC();

    for (int layer = 0; layer < DEPTH; ++layer) {
        const float* mod = modall + (size_t)layer * 9 * NMOD;
        const float* src_lat = layer == 0 ? p.x : p.out;
        const float* src_ctx = layer == 0 ? p.ctx : xctx;
        { FRESH_IDS(); phase_norm(src_lat, src_ctx, p.g_norm1 + layer * DM, mod, 0, DM, H, gw, ngw, lane); }
        GSYNC();
#ifndef NO_G1
        {
            pg8::Gemm g{H, (const bf16_t*)(ws + OFF_WIN) + (size_t)layer * UW * DM, NR, UW, DM};
            pg8::StaticOrder S; S.init(NR, UW, G, (int)blockIdx.x);
            pg8::EpiBf16<0> E{(bf16_t*)(ws + OFF_U), UW, 0, nullptr, 1312};
            pg8::gemm_phase<pg8::EpiBf16<0>, pg8::StaticOrder, true, true>(lds, g, S, E);
        }
#endif
        GSYNC();
#ifndef NO_PREP
        { FRESH_IDS(); phase_prep1(p, layer, gw, ngw, lane); }
#endif
        GSYNC();
#ifndef NO_G2
        {
            pg8::Gemm g{(const bf16_t*)(ws + OFF_CQN), (const bf16_t*)(ws + OFF_WUQ) + (size_t)layer * 768 * 256, NR, 768, 256};
            pg8::StaticOrder S; S.init(NR, 768, G, (int)blockIdx.x);
            pg8::EpiBf16<0> E{(bf16_t*)(ws + OFF_QMRAW), 768, 0, nullptr, 576};
            pg8::gemm_phase<pg8::EpiBf16<0>, pg8::StaticOrder, true, true>(lds, g, S, E);
        }
#endif
#ifndef NO_G3
        {
            pg8::Gemm g{(const bf16_t*)(ws + OFF_CKVN), (const bf16_t*)(ws + OFF_WUKV) + (size_t)layer * 768 * 128, NR, 768, 128};
            pg8::StaticOrder S; S.init(NR, 768, G, (int)blockIdx.x);
            pg8::EpiBf16<0> E{(bf16_t*)(ws + OFF_KVRAW), 768, 0, nullptr, 768};
            pg8::gemm_phase<pg8::EpiBf16<0>, pg8::StaticOrder, true, true>(lds, g, S, E);
        }
#endif
#ifndef NO_G4
        {
            pg8::Gemm g{(const bf16_t*)(ws + OFF_Y), (const bf16_t*)(ws + OFF_WPOOL) + (size_t)layer * 65536, NR, 256, 256};
            pg8::StaticOrder S; S.init(NR, 256, G, (int)blockIdx.x);
            pg8::EpiBf16<0> E{(bf16_t*)(ws + OFF_MIX), 1024, 768, nullptr, 256};
            pg8::gemm_phase<pg8::EpiBf16<0>, pg8::StaticOrder, true, true>(lds, g, S, E);
        }
#endif
        GSYNC();
#ifndef NO_PREP
        { FRESH_IDS(); phase_prep2(p, layer, gw, ngw, lane); }
#endif
        GSYNC();
#ifndef NO_ATTN
        phase_attn(p, lds, G, layer != DEPTH - 1, layer);
#endif
        GSYNC();
#ifndef NO_G5
        {
            pg8::Gemm g{(const bf16_t*)(ws + OFF_MIX), (const bf16_t*)(ws + OFF_WOUT) + (size_t)layer * DM * DM, NR, DM, DM};
            pg8::StaticOrder S; S.init(NR, DM, G, (int)blockIdx.x, layer == DEPTH - 1);
            pg8::EpiResid E{src_lat, src_ctx, p.out, xctx, mod + 2 * DM};
            pg8::gemm_phase<pg8::EpiResid, pg8::StaticOrder, true, true>(lds, g, S, E);
        }
#endif
        GSYNC();
        { FRESH_IDS(); phase_norm(p.out, xctx, p.g_norm2 + layer * DM, mod, 3 * DM, 4 * DM, H, gw, ngw, lane); }
        GSYNC();
#ifndef NO_G6
        {
            pg8::Gemm g{H, (const bf16_t*)(ws + OFF_W1) + (size_t)layer * DFF * DM, NR, DFF, DM};
            pg8::StaticOrder S; S.init(NR, DFF, G, (int)blockIdx.x, layer == DEPTH - 1);
            pg8::EpiBf16<2> E{(bf16_t*)(ws + OFF_A1), DFF, 0, nullptr, DFF};
            pg8::gemm_phase<pg8::EpiBf16<2>, pg8::StaticOrder, true, true>(lds, g, S, E);
        }
#endif
        GSYNC();
#ifndef NO_G7
        {
            pg8::Gemm g{(const bf16_t*)(ws + OFF_A1), (const bf16_t*)(ws + OFF_W2) + (size_t)layer * DM * DFF, NR, DM, DFF};
            pg8::StaticOrder S; S.init(NR, DM, G, (int)blockIdx.x, layer == DEPTH - 1);
            pg8::EpiResid E{p.out, xctx, p.out, xctx, mod + 5 * DM};
            pg8::gemm_phase<pg8::EpiResid, pg8::StaticOrder, true, true>(lds, g, S, E);
        }
#endif
        GSYNC();
    }
}

extern "C" void kernel_launch(void* const* d_in, const int* in_sizes, int n_in, void* d_out, int out_size, void* d_ws, size_t ws_size, hipStream_t stream) {
    static int grid_blocks = 0;
    if (grid_blocks == 0) {
        if (n_in != 22 || ws_size < WS_NEED) { fprintf(stderr, "kernel_launch: need 22 inputs and %zu bytes of workspace; got %d inputs, %zu bytes\n", (size_t)WS_NEED, n_in, ws_size); grid_blocks = -1; return; }
        int dev = 0, cus = 0, per_cu = 0;
        hipGetDevice(&dev);
        hipDeviceGetAttribute(&cus, hipDeviceAttributeMultiprocessorCount, dev);
        hipFuncSetAttribute((const void*)mega_fwd, hipFuncAttributeMaxDynamicSharedMemorySize, LDS_BYTES);
        hipOccupancyMaxActiveBlocksPerMultiprocessor(&per_cu, (const void*)mega_fwd, NTHREADS, LDS_BYTES);
        if (per_cu < 1) per_cu = 1;
        (void)hipGetLastError();
        grid_blocks = cus * per_cu;
        if (grid_blocks > 256) grid_blocks = 256;
    }
    if (grid_blocks < 0) return;
    Params p{};
    p.x = (const float*)d_in[0]; p.c = (const float*)d_in[1]; p.ctx = (const float*)d_in[2]; p.c_ctx = (const float*)d_in[3];
    p.w_mod = (const float*)d_in[4]; p.b_mod = (const float*)d_in[5]; p.g_norm1 = (const float*)d_in[6]; p.g_norm2 = (const float*)d_in[7];
    p.w_in = (const float*)d_in[8]; p.g_q_gqa = (const float*)d_in[9]; p.g_k_gqa = (const float*)d_in[10]; p.g_cq = (const float*)d_in[11]; p.g_ckv = (const float*)d_in[12];
    p.w_uq = (const float*)d_in[13]; p.w_ukv = (const float*)d_in[14]; p.g_q_mla = (const float*)d_in[15]; p.g_k_mla = (const float*)d_in[16];
    p.w_pool = (const float*)d_in[17]; p.ls_pool = (const float*)d_in[18]; p.w_out = (const float*)d_in[19]; p.w_mlp1 = (const float*)d_in[20]; p.w_mlp2 = (const float*)d_in[21];
    p.out = (float*)d_out; p.ws = (unsigned char*)d_ws;
    (void)hipMemsetAsync((unsigned char*)d_ws + OFF_BAR, 0, XCD_BAR_WORDS * 4, stream);
    void* args[] = {&p};
    hipError_t e = hipLaunchCooperativeKernel((const void*)mega_fwd, dim3(grid_blocks), dim3(NTHREADS), args, LDS_BYTES, stream);
    if (e != hipSuccess) fprintf(stderr, "cooperative launch failed: %s (grid %d)\n", hipGetErrorString(e), grid_blocks);
}
```

```cpp
#include <hip/hip_runtime.h>
#include <hip/hip_cooperative_groups.h>
#include <cstdio>
#include <cstdint>
namespace cg = cooperative_groups;
namespace pg8 {
#define PG8_LAS __attribute__((address_space(3)))
typedef unsigned short bf16_t;
typedef short bf16x8 __attribute__((ext_vector_type(8)));
typedef float f32x4 __attribute__((ext_vector_type(4)));
typedef unsigned u32x4 __attribute__((ext_vector_type(4)));
constexpr int BM = 256, BK = 64, HALF = 128, HTB = HALF * BK * 2  , STAGE_BYTES = 8 * HTB, NXCD = 8, WGM = 8;

__host__ __device__ __forceinline__ int lds_byte(int r, int c) { const int st = (r >> 4) * 2 + (c >> 5), rr = r & 15, cc = c & 31, ob = rr * 64 + cc * 2; return st * 1024 + (ob ^ (((ob >> 9) & 1) << 5)); }
__host__ __device__ __forceinline__ void stage_rc(int b, int& R, int& C) { const int st = b / 1024, sb = b % 1024, swz = sb ^ (((sb >> 9) & 1) << 5); R = (st >> 1) * 16 + swz / 64; C = (st & 1) * 32 + (swz % 64) / 2; }
__host__ __device__ __forceinline__ int perm32(int rho) { const int n = rho >> 4, i = rho & 15; return 8 * (i >> 2) + 4 * n + (i & 3); }

struct Unit { int pm, pn, ks; };
struct Gemm { const bf16_t* A; const bf16_t* Bt; int M, N, K, ld; };

struct StaticOrder {
    int nM, nN, nwg, G, c, skipctx;
    __host__ __device__ void init(int M, int N, int G_, int c_, int skipctx_ = 0) { nM = M / BM; if (skipctx_) nM -= nM / 33; nN = N / BM; nwg = nM * nN; G = G_; c = c_; skipctx = skipctx_; }
    __host__ __device__ bool next(int i, Unit& u) const {
        const long L = (long)i * G + c; if (L >= nwg) return false;
        int wgid = (int)L; { const int q = nwg / NXCD, r = nwg % NXCD, xcd = wgid % NXCD, off = wgid / NXCD; wgid = (xcd < r ? xcd * (q + 1) : r * (q + 1) + (xcd - r) * q) + off; }
        const int nig = WGM * nN, gid = wgid / nig, fm = gid * WGM, gsz = (nM - fm) < WGM ? (nM - fm) : WGM;
        u.pm = fm + ((wgid % nig) % gsz); u.pn = (wgid % nig) / gsz; u.ks = 0; if (skipctx) u.pm += u.pm / 32 + 1; return true;
    }
    __device__ __forceinline__ void a_ready(const Unit&) const {}
    __device__ __forceinline__ void done(const Unit&) const {}
};
struct SplitKCtx {
    int G, c;
    __host__ __device__ void init(int G_, int c_) { G = G_; c = c_; }
    __host__ __device__ bool next(int i, Unit& u) const { const int L = i * G + c; if (L >= 256) return false; u.ks = L & 7; u.pn = (L >> 3) & 3; u.pm = (L >> 5) * 33; return true; }
    __device__ __forceinline__ void a_ready(const Unit&) const {}
    __device__ __forceinline__ void done(const Unit&) const {}
};


__device__ __forceinline__ unsigned cvt_pk_bf16(float lo, float hi) { unsigned r; asm volatile("v_cvt_pk_bf16_f32 %0, %1, %2" : "=v"(r) : "v"(lo), "v"(hi)); return r; }
typedef float f32x2 __attribute__((ext_vector_type(2)));
typedef float f32x2_t __attribute__((ext_vector_type(2)));
typedef __bf16 bf16x2_t __attribute__((ext_vector_type(2)));
__device__ __forceinline__ unsigned pk2(float lo, float hi) { f32x2_t v = {lo, hi}; bf16x2_t b = __builtin_convertvector(v, bf16x2_t); return __builtin_bit_cast(unsigned, b); }

template <int ACT, bool SCALE = false> struct EpiBf16 {
    static constexpr bool PERM = true, AFTER_DRAIN = false;
    bf16_t* O; int ldc; int coloff; const float* colscale; int nvalid;
    __device__ __forceinline__ void operator()(const f32x4 (&acc)[2][2][4][2], const Unit& u, int wr, int wc, int fr, int fq) const {
        const int row0 = u.pm * BM + wr * 64 + fr;
        const int col0 = u.pn * BM + wc * 32 + 8 * fq;
        f32x4 cs[2][2];
        if (SCALE) {
#pragma unroll
            for (int bj = 0; bj < 2; ++bj)
#pragma unroll
                for (int n = 0; n < 2; ++n) cs[bj][n] = *(const f32x4*)(colscale + col0 + bj * HALF + 4 * n);
        }
#pragma unroll
        for (int ai = 0; ai < 2; ++ai)
#pragma unroll
            for (int m = 0; m < 4; ++m) { bf16_t* rowp = O + (size_t)(row0 + ai * HALF + m * 16) * ldc + coloff + col0;
#pragma unroll
                for (int bj = 0; bj < 2; ++bj) { f32x4 v0 = acc[ai][bj][m][0], v1 = acc[ai][bj][m][1];
                    if (ACT == 2) {
#pragma unroll
                        for (int e = 0; e < 4; ++e) { float a = fmaxf(v0[e], 0.f), b = fmaxf(v1[e], 0.f); v0[e] = a * a; v1[e] = b * b; } }
                    if (SCALE) { v0 = v0 * cs[bj][0]; v1 = v1 * cs[bj][1]; }
                    u32x4 w; w.x = pk2(v0[0], v0[1]); w.y = pk2(v0[2], v0[3]); w.z = pk2(v1[0], v1[1]); w.w = pk2(v1[2], v1[3]);
                    if (col0 + bj * HALF < nvalid) *(u32x4*)(rowp + bj * HALF) = w; } }
    }
};

struct EpiResid {
    static constexpr bool PERM = true, AFTER_DRAIN = false;
    const float* src_lat; const float* src_ctx; float* dst_lat; float* dst_ctx; const float* gate;
    __device__ __forceinline__ void operator()(const f32x4 (&acc)[2][2][4][2], const Unit& u, int wr, int wc, int fr, int fq) const {
        const int b = u.pm / 33, j = u.pm - b * 33;
        const float* sb; float* db; const float* g;
        if (j == 0) { sb = src_ctx + (size_t)b * 256 * 1024; db = dst_ctx + (size_t)b * 256 * 1024; g = gate + 8 * 6144; }
        else { const size_t o = ((size_t)b * 8192 + (size_t)(j - 1) * 256) * 1024; sb = src_lat + o; db = dst_lat + o; g = gate + b * 6144; }
        const int col0 = u.pn * BM + wc * 32 + 8 * fq;
        f32x4 gv[2][2];
#pragma unroll
        for (int bj = 0; bj < 2; ++bj)
#pragma unroll
            for (int n = 0; n < 2; ++n) gv[bj][n] = *(const f32x4*)(g + col0 + bj * HALF + n * 4);
#pragma unroll
        for (int ai = 0; ai < 2; ++ai)
#pragma unroll
            for (int m = 0; m < 4; ++m) { const size_t off = (size_t)(ai * HALF + wr * 64 + m * 16 + fr) * 1024 + col0;
#pragma unroll
                for (int bj = 0; bj < 2; ++bj)
#pragma unroll
                    for (int n = 0; n < 2; ++n) { const f32x4 bs = *(const f32x4*)(sb + off + bj * HALF + n * 4);
                        *(f32x4*)(db + off + bj * HALF + n * 4) = bs + gv[bj][n] * acc[ai][bj][m][n]; }
                if (m == 3) asm volatile("" ::: "memory"); }
    }
};

struct EpiPartial {
    static constexpr bool PERM = false, AFTER_DRAIN = false;
    float* P;
    __device__ __forceinline__ void operator()(const f32x4 (&acc)[2][2][4][2], const Unit& u, int wr, int wc, int fr, int fq) const {
        float* base = P + ((size_t)u.ks * 2048 + (size_t)(u.pm / 33) * 256) * 1024;
        const int col0 = u.pn * BM + wc * 32 + 4 * fq;
#pragma unroll
        for (int ai = 0; ai < 2; ++ai)
#pragma unroll
            for (int m = 0; m < 4; ++m) { const size_t off = (size_t)(ai * HALF + wr * 64 + m * 16 + fr) * 1024 + col0;
#pragma unroll
                for (int bj = 0; bj < 2; ++bj)
#pragma unroll
                    for (int n = 0; n < 2; ++n) *(f32x4*)(base + off + bj * HALF + n * 16) = acc[ai][bj][m][n]; }
    }
};

template <class Epi, class Sched, bool ALIGN_EPI = false, bool SP2 = false>
__device__ __forceinline__ void gemm_phase(PG8_LAS unsigned char* lds, const Gemm g, const Sched& S, const Epi& E) {
    int tid_ = threadIdx.x; asm volatile("" : "+v"(tid_));
    const int tid = tid_, wid = __builtin_amdgcn_readfirstlane(tid >> 6), lane = tid & 63, wr = wid >> 2, wc = wid & 3, fr = lane & 15, fq = lane >> 4;
    const int K = g.K, nt = K / BK, LD = g.ld ? g.ld : g.K;
    const size_t sstep = (size_t)K * 2;
    unsigned voffA[2], voffB[2];
#pragma unroll
    for (int i = 0; i < 2; ++i) { int R, C; stage_rc(tid * 16 + i * 8192, R, C); const int Rb = Epi::PERM ? ((R & ~31) + perm32(R & 31)) : R;
        voffA[i] = (unsigned)(R * LD + C) * 2u; voffB[i] = (unsigned)(Rb * LD + C) * 2u; }
    const size_t kstep = (size_t)(BK * 2);
    const size_t hstep = (size_t)HALF * LD * 2;
    const size_t tstep = 2 * hstep;
    const unsigned ldsw = (unsigned)wid * 1024u;
    const int aoff = lds_byte(wr * 64 + fr, fq * 8), boff = lds_byte(wc * 32 + fr, fq * 8);
#define PG8_SA(b, h) (((b) * 2 + (h)) * HTB)
#define PG8_SB(b, h) ((4 + (b) * 2 + (h)) * HTB)
#define PG8_STAGE(bufoff, gbase, voff) do { _Pragma("unroll") for (int _i = 0; _i < 2; ++_i) \
        __builtin_amdgcn_global_load_lds((const unsigned*)((const char*)(gbase) + (voff)[_i]), (PG8_LAS unsigned*)(lds + (bufoff) + ldsw + _i * 8192), 16, 0, 0); } while (0)
#define PG8_LDA(dst, b, h) do { _Pragma("unroll") for (int m = 0; m < 4; ++m) _Pragma("unroll") for (int k = 0; k < 2; ++k) dst[m][k] = *(const PG8_LAS bf16x8*)(lds + PG8_SA(b, h) + aoff + m * 2048 + k * 1024); } while (0)
#define PG8_LDB(dst, b, h) do { _Pragma("unroll") for (int n = 0; n < 2; ++n) _Pragma("unroll") for (int k = 0; k < 2; ++k) dst[n][k] = *(const PG8_LAS bf16x8*)(lds + PG8_SB(b, h) + boff + n * 2048 + k * 1024); } while (0)
#define PG8_MMA(ai, bj, At, Bt) do { __builtin_amdgcn_s_setprio(1); _Pragma("unroll") for (int m = 0; m < 4; ++m) _Pragma("unroll") for (int n = 0; n < 2; ++n) _Pragma("unroll") for (int k = 0; k < 2; ++k) \
        acc[ai][bj][m][n] = __builtin_amdgcn_mfma_f32_16x16x32_bf16(Bt[n][k], At[m][k], acc[ai][bj][m][n], 0, 0, 0); __builtin_amdgcn_s_setprio(0); } while (0)
#define PG8_WAIT_V(n) asm volatile("s_waitcnt vmcnt(" #n ")" ::: "memory")
#define PG8_WAIT_L(n) asm volatile("s_waitcnt lgkmcnt(" #n ")" ::: "memory")
#define PG8_BAR __builtin_amdgcn_s_barrier()
#define PG8_SCHED __builtin_amdgcn_sched_barrier(0)
    Unit cur, nxt; int ui = 0;
    if (!S.next(0, cur)) return;
    f32x4 acc[2][2][4][2];
#pragma unroll
    for (int a = 0; a < 2; ++a)
#pragma unroll
        for (int b = 0; b < 2; ++b)
#pragma unroll
            for (int m = 0; m < 4; ++m)
#pragma unroll
                for (int n = 0; n < 2; ++n) acc[a][b][m][n] = (f32x4){0.f, 0.f, 0.f, 0.f};
    bf16x8 At[4][2], B0[2][2], B1[2][2];
    const char* cA = (const char*)g.A + (size_t)cur.pm * tstep + (size_t)cur.ks * sstep; const char* cB = (const char*)g.Bt + (size_t)cur.pn * tstep + (size_t)cur.ks * sstep;
    S.a_ready(cur);
    if constexpr (SP2) {
        PG8_STAGE(PG8_SB(0, 0), cB, voffB); PG8_STAGE(PG8_SB(0, 1), cB + hstep, voffB); PG8_STAGE(PG8_SA(0, 0), cA, voffA); PG8_STAGE(PG8_SA(0, 1), cA + hstep, voffA);
        if (wr == 1) PG8_BAR;
        PG8_WAIT_V(2); PG8_BAR;
        PG8_STAGE(PG8_SB(1, 0), cB + kstep, voffB); PG8_STAGE(PG8_SA(1, 0), cA + kstep, voffA); PG8_STAGE(PG8_SB(1, 1), cB + hstep + kstep, voffB);
        PG8_WAIT_V(6); PG8_BAR;
    } else {
        PG8_STAGE(PG8_SB(0, 0), cB, voffB); PG8_STAGE(PG8_SA(0, 0), cA, voffA); PG8_STAGE(PG8_SB(0, 1), cB + hstep, voffB); PG8_STAGE(PG8_SA(0, 1), cA + hstep, voffA);
        if (wr == 1) PG8_BAR;
        PG8_WAIT_V(4); PG8_BAR;
        PG8_STAGE(PG8_SB(1, 0), cB + kstep, voffB); PG8_STAGE(PG8_SA(1, 0), cA + kstep, voffA); PG8_STAGE(PG8_SB(1, 1), cB + hstep + kstep, voffB);
        PG8_WAIT_V(6); PG8_BAR;
    }
    for (;;) {
        const bool has_next = S.next(ui + 1, nxt);
        const char* nA = has_next ? (const char*)g.A + (size_t)nxt.pm * tstep + (size_t)nxt.ks * sstep : cA; const char* nB = has_next ? (const char*)g.Bt + (size_t)nxt.pn * tstep + (size_t)nxt.ks * sstep : cB;
        for (int t = 0; t < nt; t += 2) {
            const bool last = (t == nt - 2);
            const char* a1 = cA + (size_t)(t + 1) * kstep;
            const char* a2 = last ? nA : cA + (size_t)(t + 2) * kstep; const char* b2 = last ? nB : cB + (size_t)(t + 2) * kstep;
            const char* a3 = a2 + kstep; const char* b3 = b2 + kstep;
            if (last && has_next) S.a_ready(nxt);
            if constexpr (SP2) {
            PG8_LDB(B0, 0, 0); PG8_LDB(B1, 0, 1); PG8_SCHED; PG8_LDA(At, 0, 0); PG8_STAGE(PG8_SA(1, 1), a1 + hstep, voffA);
            PG8_WAIT_V(8); PG8_WAIT_L(0); PG8_BAR; PG8_MMA(0, 0, At, B0); PG8_MMA(0, 1, At, B1); PG8_BAR; PG8_SCHED;
            PG8_LDA(At, 0, 1); PG8_STAGE(PG8_SB(0, 0), b2, voffB); PG8_STAGE(PG8_SB(0, 1), b2 + hstep, voffB); PG8_STAGE(PG8_SA(0, 0), a2, voffA);
            PG8_WAIT_V(8); PG8_WAIT_L(0); PG8_BAR; PG8_MMA(1, 0, At, B0); PG8_MMA(1, 1, At, B1); PG8_BAR; PG8_SCHED;
            PG8_LDB(B0, 1, 0); PG8_LDB(B1, 1, 1); PG8_SCHED; PG8_LDA(At, 1, 0); PG8_STAGE(PG8_SA(0, 1), a2 + hstep, voffA);
            PG8_WAIT_V(8); PG8_WAIT_L(0); PG8_BAR; PG8_MMA(0, 0, At, B0); PG8_MMA(0, 1, At, B1); PG8_BAR; PG8_SCHED;
            PG8_LDA(At, 1, 1); PG8_STAGE(PG8_SB(1, 0), b3, voffB); PG8_STAGE(PG8_SB(1, 1), b3 + hstep, voffB); PG8_STAGE(PG8_SA(1, 0), a3, voffA);
            PG8_WAIT_V(8); PG8_WAIT_L(0); PG8_BAR; PG8_MMA(1, 0, At, B0); PG8_MMA(1, 1, At, B1); PG8_BAR; PG8_SCHED;
            } else {
            PG8_LDB(B0, 0, 0); PG8_SCHED; PG8_LDA(At, 0, 0); PG8_STAGE(PG8_SA(1, 1), a1 + hstep, voffA);
            PG8_WAIT_L(8); PG8_BAR; PG8_WAIT_L(0); PG8_MMA(0, 0, At, B0); PG8_BAR; PG8_SCHED;
            PG8_LDB(B1, 0, 1); PG8_STAGE(PG8_SB(0, 0), b2, voffB);
            PG8_BAR; PG8_WAIT_L(0); PG8_MMA(0, 1, At, B1); PG8_BAR;
            PG8_LDA(At, 0, 1); PG8_STAGE(PG8_SA(0, 0), a2, voffA);
            PG8_BAR; PG8_WAIT_L(0); PG8_MMA(1, 0, At, B0); PG8_BAR; PG8_SCHED;
            PG8_STAGE(PG8_SB(0, 1), b2 + hstep, voffB);
            PG8_WAIT_V(6); PG8_BAR; PG8_MMA(1, 1, At, B1); PG8_BAR;
            PG8_LDB(B0, 1, 0); PG8_SCHED; PG8_LDA(At, 1, 0); PG8_STAGE(PG8_SA(0, 1), a2 + hstep, voffA);
            PG8_WAIT_L(8); PG8_BAR; PG8_WAIT_L(0); PG8_MMA(0, 0, At, B0); PG8_BAR; PG8_SCHED;
            PG8_LDB(B1, 1, 1); PG8_STAGE(PG8_SB(1, 0), b3, voffB);
            PG8_BAR; PG8_WAIT_L(0); PG8_MMA(0, 1, At, B1); PG8_BAR;
            PG8_LDA(At, 1, 1); PG8_STAGE(PG8_SA(1, 0), a3, voffA);
            PG8_BAR; PG8_WAIT_L(0); PG8_MMA(1, 0, At, B0); PG8_BAR; PG8_SCHED;
            PG8_STAGE(PG8_SB(1, 1), b3 + hstep, voffB);
            PG8_WAIT_V(6); PG8_BAR; PG8_MMA(1, 1, At, B1); PG8_BAR;
            }
        }
        if constexpr (ALIGN_EPI) { if (wr == 0) PG8_BAR; }
        if constexpr (!Epi::AFTER_DRAIN) { int t2_ = tid; asm volatile("" : "+v"(t2_));
            E(acc, cur, wr, wc, t2_ & 15, (t2_ & 63) >> 4); S.done(cur); }
        if (!has_next) break;
#pragma unroll
        for (int a = 0; a < 2; ++a)
#pragma unroll
            for (int b = 0; b < 2; ++b)
#pragma unroll
                for (int m = 0; m < 4; ++m)
#pragma unroll
                    for (int n = 0; n < 2; ++n) acc[a][b][m][n] = (f32x4){0.f, 0.f, 0.f, 0.f};
        cur = nxt; cA = nA; cB = nB; ++ui;
        if constexpr (ALIGN_EPI) { if (wr == 1) PG8_BAR; }
    }
    PG8_WAIT_V(0);
    if constexpr (!ALIGN_EPI) { if (wr == 0) PG8_BAR; }
    PG8_BAR;
    if constexpr (Epi::AFTER_DRAIN) { E.fused(acc, cur, wr, wc, fr, fq, lds, wid, lane); S.done(cur); }
#undef PG8_SA
#undef PG8_SB
#undef PG8_STAGE
#undef PG8_LDA
#undef PG8_LDB
#undef PG8_MMA
#undef PG8_WAIT_V
#undef PG8_WAIT_L
#undef PG8_BAR
#undef PG8_SCHED
}
}

#define LAS __attribute__((address_space(3)))
typedef unsigned short bf16_t;
typedef short bf16x8 __attribute__((ext_vector_type(8)));
typedef float f32x4 __attribute__((ext_vector_type(4)));
typedef float f32x16 __attribute__((ext_vector_type(16)));
typedef unsigned u32x4 __attribute__((ext_vector_type(4)));
typedef unsigned u32x2 __attribute__((ext_vector_type(2)));
using pg8::pk2;

constexpr int NB = 8, LSEQ = 8192, LCTX = 256, LTOT = LSEQ + LCTX, NR = NB * LTOT, DM = 1024, DEPTH = 4, DFF = 4096;
constexpr int UW = 1536;
constexpr int NMOD = 6 * DM;
constexpr float EPS = 1e-6f;
constexpr float LOG2E = 1.4426950408889634f;
constexpr float QSCALE_G = 0.125f * LOG2E;
constexpr float QSCALE_M = 0.10206207261596575f * LOG2E;
constexpr int NWAVES = 8, NTHREADS = 512;
constexpr int LDS_BYTES = 131072 + 512;

constexpr size_t MiB = 1u << 20;
constexpr size_t COLB = (size_t)NR * 2;
constexpr size_t OFF_BAR = 880 * 1024;
constexpr size_t OFF_MOD = 0, OFF_MODP = 1 * MiB, OFF_ROPEG = 5 * MiB, OFF_ROPEM = 7 * MiB, OFF_XCTX = 8 * MiB;
constexpr size_t OFF_WIN = 16 * MiB, OFF_WUQ = 28 * MiB, OFF_WUKV = 30 * MiB, OFF_WPOOL = 31 * MiB, OFF_WOUT = 32 * MiB, OFF_W1 = 40 * MiB, OFF_W2 = 72 * MiB;
constexpr size_t OFF_H = 104 * MiB;
constexpr size_t OFF_R = 236 * MiB;
constexpr size_t OFF_U = OFF_R;
constexpr size_t OFF_QMRAW = OFF_U, OFF_KVRAW = OFF_U + 768 * COLB;
constexpr size_t OFF_CQN = OFF_U + 1536 * COLB;
constexpr size_t OFF_CKVN = OFF_CQN + 256 * COLB;
constexpr size_t OFF_Y = OFF_CKVN + 128 * COLB;
constexpr size_t OFF_KR = OFF_Y + 256 * COLB;
constexpr size_t OFF_QG = OFF_KR + 32 * COLB;
constexpr size_t OFF_KG = OFF_QG + 384 * COLB;
constexpr size_t OFF_VTG = OFF_KG + 128 * COLB;
constexpr size_t OFF_QM = OFF_VTG + 128 * COLB;
constexpr size_t OFF_KM = OFF_QM + 576 * COLB;
constexpr size_t OFF_VTM = OFF_KM + 576 * COLB;
constexpr size_t OFF_MIX = OFF_VTM + 384 * COLB;
constexpr size_t OFF_REND = OFF_MIX + 1024 * COLB;
constexpr size_t OFF_A1 = OFF_R;
constexpr size_t WS_NEED = (OFF_REND > OFF_A1 + 4096 * COLB) ? OFF_REND : OFF_A1 + 4096 * COLB;
static_assert(OFF_MODP + 4 * DEPTH * 9 * NMOD * 4 <= OFF_ROPEG, "ws map");
static_assert(OFF_A1 + 4096 * COLB <= OFF_REND + 1, "A1 inside R");

struct Params {
    const float *x, *c, *ctx, *c_ctx, *w_mod, *b_mod, *g_norm1, *g_norm2, *w_in, *g_q_gqa, *g_k_gqa, *g_cq, *g_ckv, *w_uq, *w_ukv, *g_q_mla, *g_k_mla, *w_pool, *ls_pool, *w_out, *w_mlp1, *w_mlp2;
    float* out; unsigned char* ws;
};

__device__ __forceinline__ float bf2f(unsigned short h) { return __uint_as_float((unsigned)h << 16); }
__device__ __forceinline__ void unpack8(const u32x4 w, float (&v)[8]) {
    v[0] = __uint_as_float(w.x << 16); v[1] = __uint_as_float(w.x & 0xffff0000u); v[2] = __uint_as_float(w.y << 16); v[3] = __uint_as_float(w.y & 0xffff0000u);
    v[4] = __uint_as_float(w.z << 16); v[5] = __uint_as_float(w.z & 0xffff0000u); v[6] = __uint_as_float(w.w << 16); v[7] = __uint_as_float(w.w & 0xffff0000u);
}
__device__ __forceinline__ void unpack4(const u32x2 w, float (&v)[4]) {
    v[0] = __uint_as_float(w.x << 16); v[1] = __uint_as_float(w.x & 0xffff0000u); v[2] = __uint_as_float(w.y << 16); v[3] = __uint_as_float(w.y & 0xffff0000u);
}
__device__ __forceinline__ u32x4 pack8(const float (&v)[8]) { u32x4 w; w.x = pk2(v[0], v[1]); w.y = pk2(v[2], v[3]); w.z = pk2(v[4], v[5]); w.w = pk2(v[6], v[7]); return w; }
template <int M> __device__ __forceinline__ float swz_xor(float v) { return __int_as_float(__builtin_amdgcn_ds_swizzle(__float_as_int(v), (M << 10) | 0x1f)); }
__device__ __forceinline__ float xhalf_add(float v) { auto rr = __builtin_amdgcn_permlane32_swap(__float_as_uint(v), __float_as_uint(v), false, false); return __uint_as_float(rr[0]) + __uint_as_float(rr[1]); }
__device__ __forceinline__ float xhalf_max(float v) { auto rr = __builtin_amdgcn_permlane32_swap(__float_as_uint(v), __float_as_uint(v), false, false); return fmaxf(__uint_as_float(rr[0]), __uint_as_float(rr[1])); }
__device__ __forceinline__ float wave_sum(float v) {
    v += swz_xor<1>(v); v += swz_xor<2>(v); v += swz_xor<4>(v); v += swz_xor<8>(v); v += swz_xor<16>(v);
    return xhalf_add(v);
}
__device__ __forceinline__ int perm16(int p) { return (p & ~12) | ((p & 4) << 1) | ((p & 8) >> 1); }

__device__ __forceinline__ void transpose_item(const float* W, int K, int N, bf16_t* WT, LAS float* scr, int item, int lane) {
    const int nblk = N / 32, kb = item / nblk, nb = item % nblk, k0 = 64 * kb, n0 = 32 * nb;
#pragma unroll 8
    for (int i = 0; i < 32; ++i) { const int kk = 2 * i + (lane >> 5); scr[kk * 33 + (lane & 31)] = W[(size_t)(k0 + kk) * N + n0 + (lane & 31)]; }
    asm volatile("s_waitcnt lgkmcnt(0)" ::: "memory");
    const int c = lane & 7;
#pragma unroll
    for (int j = 0; j < 4; ++j) { const int n = (lane >> 3) + 8 * j; const LAS float* s = scr + (8 * c) * 33 + n;
        u32x4 o; o.x = pk2(s[0 * 33], s[1 * 33]); o.y = pk2(s[2 * 33], s[3 * 33]); o.z = pk2(s[4 * 33], s[5 * 33]); o.w = pk2(s[6 * 33], s[7 * 33]);
        *(u32x4*)(WT + (size_t)(n0 + n) * K + k0 + 8 * c) = o; }
    asm volatile("s_waitcnt lgkmcnt(0)" ::: "memory");
}

__device__ __forceinline__ void phase_prologue(const Params& p, LAS unsigned char* lds, int G) {
    const int tid = threadIdx.x, lane = tid & 63, wid = tid >> 6;
    const int gw = blockIdx.x * NWAVES + wid, ngw = G * NWAVES;
    const int gt = blockIdx.x * NTHREADS + tid, ngt = G * NTHREADS;
    unsigned char* ws = p.ws;
    LAS float* sv = (LAS float*)(lds + 71680);
    for (int i = tid; i < 9 * DM; i += NTHREADS) { const float v = (i < 8 * DM) ? p.c[i] : p.c_ctx[i - 8 * DM]; sv[i] = v / (1.f + __expf(-v)); }
    __syncthreads();
    {
        float* modp = (float*)(ws + OFF_MODP);
        for (int it = gt; it < DEPTH * 4 * NMOD; it += ngt) {
            const int n = it % NMOD, ks = (it / NMOD) & 3, l = it / (4 * NMOD);
            const float* w = p.w_mod + ((size_t)l * DM + ks * 256) * NMOD + n;
            float acc[9];
#pragma unroll
            for (int j = 0; j < 9; ++j) acc[j] = 0.f;
#pragma unroll 2
            for (int k = 0; k < 256; k += 4) {
                const float w0 = w[(size_t)k * NMOD], w1 = w[(size_t)(k + 1) * NMOD], w2 = w[(size_t)(k + 2) * NMOD], w3 = w[(size_t)(k + 3) * NMOD];
#pragma unroll
                for (int j = 0; j < 9; ++j) { const f32x4 s = *(const LAS f32x4*)(sv + j * DM + ks * 256 + k); acc[j] += s.x * w0 + s.y * w1 + s.z * w2 + s.w * w3; }
            }
#pragma unroll
            for (int j = 0; j < 9; ++j) modp[(((size_t)ks * DEPTH + l) * 9 + j) * NMOD + n] = acc[j];
        }
    }
    {
        LAS float* scr = (LAS float*)(lds + wid * 8704);
        constexpr int I_IN = 16 * 41, I_UQ = 4 * 18, I_UKV = 2 * 24, I_OUT = 12 * 32  , I_1 = 16 * 128, I_2 = 64 * 32, I_L = I_IN + I_UQ + I_UKV + I_OUT + I_1 + I_2;
        for (int it = gw; it < DEPTH * I_L; it += ngw) {
            const int l = it / I_L; int r = it - l * I_L;
            if (r < I_IN) { transpose_item(p.w_in + (size_t)l * DM * 1312, DM, 1312, (bf16_t*)(ws + OFF_WIN) + (size_t)l * UW * DM, scr, r, lane); continue; } r -= I_IN;
            if (r < I_UQ) { transpose_item(p.w_uq + (size_t)l * 256 * 576, 256, 576, (bf16_t*)(ws + OFF_WUQ) + (size_t)l * 768 * 256, scr, r, lane); continue; } r -= I_UQ;
            if (r < I_UKV) { transpose_item(p.w_ukv + (size_t)l * 128 * 768, 128, 768, (bf16_t*)(ws + OFF_WUKV) + (size_t)l * 768 * 128, scr, r, lane); continue; } r -= I_UKV;
            if (r < I_OUT) { transpose_item(p.w_out + (size_t)l * DM * DM, DM, DM, (bf16_t*)(ws + OFF_WOUT) + (size_t)l * DM * DM, scr, r, lane); continue; } r -= I_OUT;
            if (r < I_1) { transpose_item(p.w_mlp1 + (size_t)l * DM * DFF, DM, DFF, (bf16_t*)(ws + OFF_W1) + (size_t)l * DFF * DM, scr, r, lane); continue; } r -= I_1;
            transpose_item(p.w_mlp2 + (size_t)l * DFF * DM, DFF, DM, (bf16_t*)(ws + OFF_W2) + (size_t)l * DM * DFF, scr, r, lane);
        }
    }
    {
        const u32x4 z = {0u, 0u, 0u, 0u};
        constexpr int ZIN = 224 * DM / 8, ZUQ = 192 * 256 / 8;
        for (int it = gt; it < DEPTH * (ZIN + ZUQ); it += ngt) {
            const int l = it / (ZIN + ZUQ), r = it - l * (ZIN + ZUQ);
            if (r < ZIN) *(u32x4*)((bf16_t*)(ws + OFF_WIN) + (size_t)l * UW * DM + (size_t)1312 * DM + (size_t)r * 8) = z;
            else *(u32x4*)((bf16_t*)(ws + OFF_WUQ) + (size_t)l * 768 * 256 + (size_t)576 * 256 + (size_t)(r - ZIN) * 8) = z;
        }
    }
    {
        float* tg = (float*)(ws + OFF_ROPEG); float* tm = (float*)(ws + OFF_ROPEM);
        for (int it = gt; it < LSEQ * 48; it += ngt) {
            const int t = it / 48, j = it - t * 48;
            const int row = t >> 6, col = t & 63;
            double pos, e;
            if (j < 32) { pos = (j < 16) ? (double)row : (double)col; e = (double)(j & 15) / 16.0; }
            else { const int jj = j - 32; pos = (jj < 8) ? (double)row : (double)col; e = (double)(jj & 7) / 8.0; }
            const float inv = (float)exp2(-e * 13.287712379549449);
            const float angf = (float)pos * inv;
            const double a = (double)angf;
            const double kk = rint(a * 0.15915494309189535);
            const float rr = (float)(a - kk * 6.283185307179586);
            const float cs = __cosf(rr), sn = __sinf(rr);
            if (j < 32) { tg[t * 64 + j] = cs; tg[t * 64 + 32 + j] = sn; }
            else { tm[t * 32 + (j - 32)] = cs; tm[t * 32 + 16 + (j - 32)] = sn; }
        }
    }
}

__device__ __forceinline__ void phase_poolfold(const Params& p, int l, int G) {
    int tid_ = threadIdx.x; asm volatile("" : "+v"(tid_));
    const int gt = blockIdx.x * NTHREADS + tid_, ngt = G * NTHREADS;
    for (int it = gt; it < DM * 256; it += ngt) {
        const int kk = it & 255, n = it >> 8;
        const int g = kk >> 6, cc = kk & 63;
        const float* wp = p.w_pool + (((size_t)l * 4 + g) * 64 + cc) * 64;
        const float* ls = p.ls_pool + l * 256 + g * 64;
        const float* wo = p.w_out + ((size_t)l * DM + 768 + g * 64) * DM + n;
        float acc = 0.f;
#pragma unroll 16
        for (int d = 0; d < 64; ++d) acc += (wp[d] * ls[d]) * wo[(size_t)d * DM];
        ((bf16_t*)(p.ws + OFF_WOUT))[((size_t)l * DM + n) * DM + 768 + kk] = (bf16_t)(pk2(acc, 0.f) & 0xffffu);
    }
}

__device__ __forceinline__ void phase_modfinal(const Params& p, int G) {
    const int gt = blockIdx.x * NTHREADS + threadIdx.x, ngt = G * NTHREADS;
    const float* modp = (const float*)(p.ws + OFF_MODP); float* mod = (float*)(p.ws + OFF_MOD);
    constexpr int TOT = DEPTH * 9 * NMOD;
    for (int it = gt; it < TOT; it += ngt) {
        const int n = it % NMOD, l = it / (9 * NMOD);
        mod[it] = p.b_mod[l * NMOD + n] + ((modp[it] + modp[TOT + it]) + (modp[2 * TOT + it] + modp[3 * TOT + it]));
    }
}

__device__ __forceinline__ f32x4 ldg4(const float* p) { return *(const f32x4*)p; }
__device__ __forceinline__ void phase_norm(const float* lat, const float* ctx, const float* g, const float* mod, int shoff, int scoff, bf16_t* H, int gw, int ngw, int lane) {
    constexpr int R = 3;
    f32x4 gg[4];
#pragma unroll
    for (int j = 0; j < 4; ++j) gg[j] = ldg4(g + 4 * (lane + 64 * j));
    for (int gi = gw; gi < NR / R; gi += ngw) {
        const int r0 = gi * R;
        f32x4 v[R][4]; const float* md[R];
#pragma unroll
        for (int q = 0; q < R; ++q) {
            const int r = r0 + q, b = r / LTOT, pp = r - b * LTOT;
            const float* xr;
            if (pp < LCTX) { xr = ctx + ((size_t)b * LCTX + pp) * DM; md[q] = mod + 8 * NMOD; }
            else { xr = lat + ((size_t)b * LSEQ + (pp - LCTX)) * DM; md[q] = mod + b * NMOD; }
#pragma unroll
            for (int j = 0; j < 4; ++j) v[q][j] = __builtin_nontemporal_load((const f32x4*)xr + lane + 64 * j);
        }
        f32x4 sh[R][4], sc[R][4];
#pragma unroll
        for (int q = 0; q < R; ++q)
#pragma unroll
            for (int j = 0; j < 4; ++j) { const int col = 4 * (lane + 64 * j); sh[q][j] = ldg4(md[q] + shoff + col); sc[q][j] = ldg4(md[q] + scoff + col); }
#pragma unroll
        for (int q = 0; q < R; ++q) {
            float ss = 0.f;
#pragma unroll
            for (int j = 0; j < 4; ++j) ss += (v[q][j].x * v[q][j].x + v[q][j].y * v[q][j].y) + (v[q][j].z * v[q][j].z + v[q][j].w * v[q][j].w);
            ss = wave_sum(ss);
            const float rstd = 1.0f / sqrtf(ss * (1.0f / DM) + EPS);
#pragma unroll
            for (int j = 0; j < 4; ++j) {
                const int col = 4 * (lane + 64 * j);
                const f32x4 y = (v[q][j] * rstd) * gg[j] * (sc[q][j] + 1.0f) + sh[q][j];
                u32x2 w; w.x = pk2(y.x, y.y); w.y = pk2(y.z, y.w);
                *(u32x2*)(H + (size_t)(r0 + q) * DM + col) = w;
            }
        }
    }
}

__device__ __forceinline__ void phase_prep1(const Params& p, int layer, int gw, int ngw, int lane) {
    constexpr int R = 2;
    unsigned char* ws = p.ws;
    const bf16_t* U = (const bf16_t*)(ws + OFF_U);
    bf16_t* Qg = (bf16_t*)(ws + OFF_QG); bf16_t* Kg = (bf16_t*)(ws + OFF_KG); bf16_t* Vg = (bf16_t*)(ws + OFF_VTG);
    bf16_t* CQn = (bf16_t*)(ws + OFF_CQN); bf16_t* CKVn = (bf16_t*)(ws + OFF_CKVN); bf16_t* KR = (bf16_t*)(ws + OFF_KR); bf16_t* Y = (bf16_t*)(ws + OFF_MIX) + 768;
    const float* tabg = (const float*)(ws + OFF_ROPEG);
    const int ch = (lane + 16) & 63;
    float g1[8], g2[8];
    {
        const float* gv = ((lane < 48) ? p.g_q_gqa : p.g_k_gqa) + layer * 64 + 8 * (lane & 7);
        const f32x4 a = ldg4(gv), b = ldg4(gv + 4);
        g1[0] = a.x; g1[1] = a.y; g1[2] = a.z; g1[3] = a.w; g1[4] = b.x; g1[5] = b.y; g1[6] = b.z; g1[7] = b.w;
        const float* gw2 = (ch < 16) ? (p.g_cq + layer * 256) : (ch < 48) ? (p.g_cq + layer * 256 + 8 * (ch - 16)) : (p.g_ckv + layer * 128 + 8 * (ch - 48));
        const f32x4 c = ldg4(gw2), d = ldg4(gw2 + 4);
        g2[0] = c.x; g2[1] = c.y; g2[2] = c.z; g2[3] = c.w; g2[4] = d.x; g2[5] = d.y; g2[6] = d.z; g2[7] = d.w;
    }
    const int gi_ = lane >> 4, half = 1 << gi_;
    for (int gidx = gw; gidx < NR / R; gidx += ngw) {
        const int r0 = gidx * R;
        u32x4 w1[R], w2[R], wk[R]; u32x2 wp[R], nb[R][16]; f32x4 rc[R][2], rs[R][2];
        bool isctx[R]; int lo[R], hi[R];
#pragma unroll
        for (int q = 0; q < R; ++q) {
            const int r = r0 + q, b = r / LTOT, pp = r - b * LTOT;
            isctx[q] = pp < LCTX; const int t = isctx[q] ? 0 : pp - LCTX;
            const bf16_t* u = U + (size_t)r * UW;
            w1[q] = __builtin_nontemporal_load((const u32x4*)(u + 8 * lane));
            w2[q] = __builtin_nontemporal_load((const u32x4*)(u + 512 + 8 * ch));
            wk[q] = *(const u32x4*)(u + 1024 + 8 * (lane & 3));
            wp[q] = *(const u32x2*)(u + 1056 + 4 * lane);
            const int tt = isctx[q] ? pp : t, len = isctx[q] ? LCTX : LSEQ;
            lo[q] = max(tt - half, 0); hi[q] = min(tt + half, len);
#pragma unroll
            for (int jj = 0; jj < 16; ++jj) {
                const int j = tt + jj - 8;
                nb[q][jj] = (u32x2){0u, 0u};
                if (j >= lo[q] && j < hi[q]) nb[q][jj] = *(const u32x2*)(u + (ptrdiff_t)(jj - 8) * UW + 1056 + 4 * lane);
            }
            const float* tb = tabg + (size_t)t * 64 + 8 * (lane & 3);
            rc[q][0] = ldg4(tb); rc[q][1] = ldg4(tb + 4); rs[q][0] = ldg4(tb + 32); rs[q][1] = ldg4(tb + 36);
        }
#pragma unroll
        for (int q = 0; q < R; ++q) {
            const int r = r0 + q;
            {
                float v[8]; unpack8(w1[q], v);
                float ss = 0.f;
#pragma unroll
                for (int i = 0; i < 8; ++i) ss += v[i] * v[i];
                ss += swz_xor<1>(ss); ss += swz_xor<2>(ss); ss += swz_xor<4>(ss);
                const float rstd = 1.0f / sqrtf(ss * (1.0f / 64.0f) + EPS);
#pragma unroll
                for (int i = 0; i < 8; ++i) v[i] = v[i] * rstd * g1[i];
                const float cs[8] = {rc[q][0].x, rc[q][0].y, rc[q][0].z, rc[q][0].w, rc[q][1].x, rc[q][1].y, rc[q][1].z, rc[q][1].w};
                const float sn[8] = {rs[q][0].x, rs[q][0].y, rs[q][0].z, rs[q][0].w, rs[q][1].x, rs[q][1].y, rs[q][1].z, rs[q][1].w};
                float o[8];
#pragma unroll
                for (int i = 0; i < 8; ++i) {
                    const float pr = swz_xor<4>(v[i]);
                    if (isctx[q]) o[i] = v[i];
                    else o[i] = ((lane & 7) < 4) ? (v[i] * cs[i] - pr * sn[i]) : (pr * sn[i] + v[i] * cs[i]);
                }
                if (lane < 48) {
#pragma unroll
                    for (int i = 0; i < 8; ++i) o[i] *= QSCALE_G;
                    *(u32x4*)(Qg + (size_t)r * 384 + 8 * lane) = pack8(o);
                } else *(u32x4*)(Kg + (size_t)r * 128 + 8 * (lane - 48)) = pack8(o);
            }
            {
                float v[8]; unpack8(w2[q], v);
                float ss = 0.f;
#pragma unroll
                for (int i = 0; i < 8; ++i) ss += v[i] * v[i];
                ss += swz_xor<1>(ss); ss += swz_xor<2>(ss); ss += swz_xor<4>(ss); ss += swz_xor<8>(ss);
                const float ss2 = ss + swz_xor<16>(ss);
                if (ch < 16) {
                    *(u32x4*)(Vg + (size_t)r * 128 + 8 * ch) = w2[q];
                } else if (ch < 48) {
                    const float rstd = 1.0f / sqrtf(ss2 * (1.0f / 256.0f) + EPS);
#pragma unroll
                    for (int i = 0; i < 8; ++i) v[i] = v[i] * rstd * g2[i];
                    *(u32x4*)(CQn + (size_t)r * 256 + 8 * (ch - 16)) = pack8(v);
                } else {
                    const float rstd = 1.0f / sqrtf(ss * (1.0f / 128.0f) + EPS);
#pragma unroll
                    for (int i = 0; i < 8; ++i) v[i] = v[i] * rstd * g2[i];
                    *(u32x4*)(CKVn + (size_t)r * 128 + 8 * (ch - 48)) = pack8(v);
                }
            }
            if (lane < 4) *(u32x4*)(KR + (size_t)r * 32 + 8 * lane) = wk[q];
            {
                float v[4]; unpack4(wp[q], v);
                float s[4] = {0.f, 0.f, 0.f, 0.f};
#pragma unroll
                for (int jj = 0; jj < 16; ++jj) { float nv[4]; unpack4(nb[q][jj], nv);
#pragma unroll
                    for (int i = 0; i < 4; ++i) s[i] += nv[i]; }
                const float inv = 1.0f / (float)(hi[q] - lo[q]);
                u32x2 w; w.x = pk2(s[0] * inv - v[0], s[1] * inv - v[1]); w.y = pk2(s[2] * inv - v[2], s[3] * inv - v[3]);
                *(u32x2*)(Y + (size_t)r * 1024 + 4 * lane) = w;
            }
        }
    }
}

__device__ __forceinline__ void phase_prep2(const Params& p, int layer, int gw, int ngw, int lane) {
    constexpr int R = 3;
    unsigned char* ws = p.ws;
    const bf16_t* QMraw = (const bf16_t*)(ws + OFF_QMRAW); const bf16_t* KVraw = (const bf16_t*)(ws + OFF_KVRAW); const bf16_t* KR = (const bf16_t*)(ws + OFF_KR);
    bf16_t* Qm = (bf16_t*)(ws + OFF_QM); bf16_t* Km = (bf16_t*)(ws + OFF_KM);
    const float* tabm = (const float*)(ws + OFF_ROPEM);
    const int h = (lane < 48) ? (lane >> 3) : 5, j8 = lane & 7; const bool act = lane < 48;
    float gn[2][8], gr[2][4];
#pragma unroll
    for (int which = 0; which < 2; ++which) {
        const float* gv = (which == 0 ? p.g_q_mla : p.g_k_mla) + layer * 96;
        const f32x4 a = ldg4(gv + 8 * j8), b = ldg4(gv + 8 * j8 + 4), c = ldg4(gv + 64 + 4 * j8);
        gn[which][0] = a.x; gn[which][1] = a.y; gn[which][2] = a.z; gn[which][3] = a.w; gn[which][4] = b.x; gn[which][5] = b.y; gn[which][6] = b.z; gn[which][7] = b.w;
        gr[which][0] = c.x; gr[which][1] = c.y; gr[which][2] = c.z; gr[which][3] = c.w;
    }
    for (int gidx = gw; gidx < NR / R; gidx += ngw) {
        const int r0 = gidx * R;
        u32x4 wn[R][2]; u32x2 wr[R][2]; f32x4 rc[R], rs[R]; bool isctx[R];
#pragma unroll
        for (int q = 0; q < R; ++q) {
            const int r = r0 + q, b = r / LTOT, pp = r - b * LTOT;
            isctx[q] = pp < LCTX; const int t = isctx[q] ? 0 : pp - LCTX;
            wn[q][0] = __builtin_nontemporal_load((const u32x4*)(QMraw + (size_t)r * 768 + h * 96 + 8 * j8)); wr[q][0] = __builtin_nontemporal_load((const u32x2*)(QMraw + (size_t)r * 768 + h * 96 + 64 + 4 * j8));
            wn[q][1] = __builtin_nontemporal_load((const u32x4*)(KVraw + (size_t)r * 768 + h * 128 + 8 * j8)); wr[q][1] = *(const u32x2*)(KR + (size_t)r * 32 + 4 * j8);
            const float* tb = tabm + (size_t)t * 32 + 4 * (j8 & 3);
            rc[q] = ldg4(tb); rs[q] = ldg4(tb + 16);
        }
#pragma unroll
        for (int q = 0; q < R; ++q) {
            const int r = r0 + q;
            const float cs[4] = {rc[q].x, rc[q].y, rc[q].z, rc[q].w}, sn[4] = {rs[q].x, rs[q].y, rs[q].z, rs[q].w};
#pragma unroll
            for (int which = 0; which < 2; ++which) {
                float vn[8], vr[4]; unpack8(wn[q][which], vn); unpack4(wr[q][which], vr);
                float ss = 0.f;
#pragma unroll
                for (int i = 0; i < 8; ++i) ss += vn[i] * vn[i];
#pragma unroll
                for (int i = 0; i < 4; ++i) ss += vr[i] * vr[i];
                ss += swz_xor<1>(ss); ss += swz_xor<2>(ss); ss += swz_xor<4>(ss);
                const float rstd = 1.0f / sqrtf(ss * (1.0f / 96.0f) + EPS);
                const float qs = which == 0 ? QSCALE_M : 1.0f;
#pragma unroll
                for (int i = 0; i < 8; ++i) vn[i] = vn[i] * rstd * gn[which][i] * qs;
#pragma unroll
                for (int i = 0; i < 4; ++i) vr[i] = vr[i] * rstd * gr[which][i];
                float o[4];
#pragma unroll
                for (int i = 0; i < 4; ++i) {
                    const float pr = swz_xor<4>(vr[i]);
                    if (isctx[q]) o[i] = vr[i];
                    else o[i] = (j8 < 4) ? (vr[i] * cs[i] - pr * sn[i]) : (pr * sn[i] + vr[i] * cs[i]);
                    o[i] *= qs;
                }
                if (act) {
                    bf16_t* dst = (which == 0 ? Qm : Km) + (size_t)r * 576 + h * 96;
                    *(u32x4*)(dst + 8 * j8) = pack8(vn);
                    u32x2 w; w.x = pk2(o[0], o[1]); w.y = pk2(o[2], o[3]);
                    *(u32x2*)(dst + 64 + 4 * j8) = w;
                }
            }
        }
    }
}

typedef short s16x4 __attribute__((ext_vector_type(4)));
__device__ __forceinline__ s16x4 vtr(LAS unsigned char* p) { return __builtin_bit_cast(s16x4, __builtin_amdgcn_ds_read_tr16_b64_v4i16((LAS s16x4*)p)); }
constexpr float ATT_BMAX = 56.0f;
template <int DK> struct AttnCtx {
    static constexpr int KSTR = DK * 2 + 16, VSTR = 192, NDS = DK / 16, KCH = DK / 8, KBUF = 64 * 208, VBUF = 64 * 192;
};
template <int DK, int PAR, bool HASNEXT, bool LDK, bool LDV, bool STK>
__device__ __forceinline__ void attn_step(LAS unsigned char* lds, f32x16& C0, f32x16& C1, f32x16& N0, f32x16& N1, f32x16& o0, f32x16& o1, float& l,
                                          const bf16x8 (&qf)[DK / 16], const bf16_t* kg0, const bf16_t* kg1, const bf16_t* vg, size_t kstep, size_t vstep, int t,
                                          bool has1, int kl0, int kl1, int vl, int aoffk, int aoffv,
                                          u32x4& ldk0, u32x4& ldk1, u32x4& ldv, const u32x4& stk0, const u32x4& stk1, const u32x4& stv) {
    using A = AttnCtx<DK>;
    LAS unsigned char* Kb = lds + ((PAR ^ 1) * A::KBUF);
    LAS unsigned char* Vb = lds + 2 * A::KBUF + PAR * A::VBUF;
    __builtin_amdgcn_s_setprio(1);
    if (LDK) { ldk0 = *(const u32x4*)(kg0 + (size_t)(t + 3) * kstep); if (has1) ldk1 = *(const u32x4*)(kg1 + (size_t)(t + 3) * kstep); }
    if (LDV) ldv = *(const u32x4*)(vg + (size_t)(t + 2) * vstep);
    bf16x8 kf[A::NDS][2];
    if (HASNEXT) {
#pragma unroll
        for (int ds = 0; ds < A::NDS; ++ds) {
            kf[ds][0] = *(const LAS bf16x8*)(Kb + aoffk + ds * 32);
            kf[ds][1] = *(const LAS bf16x8*)(Kb + aoffk + 32 * A::KSTR + ds * 32);
        }
    }
    s16x4 vlo[4][2], vhi[4][2];
#pragma unroll
    for (int j = 0; j < 2; ++j) {
        vlo[j][0] = vtr(Vb + aoffv + j * 16 * A::VSTR); vhi[j][0] = vtr(Vb + aoffv + (j * 16 + 8) * A::VSTR);
        vlo[j][1] = vtr(Vb + aoffv + j * 16 * A::VSTR + 64); vhi[j][1] = vtr(Vb + aoffv + (j * 16 + 8) * A::VSTR + 64);
    }
    if (HASNEXT) {
        f32x16 z;
#pragma unroll
        for (int i = 0; i < 16; ++i) z[i] = 0.f;
#pragma unroll
        for (int ds = 0; ds < A::NDS; ++ds) {
            N0 = __builtin_amdgcn_mfma_f32_32x32x16_bf16(kf[ds][0], qf[ds], ds == 0 ? z : N0, 0, 0, 0);
            N1 = __builtin_amdgcn_mfma_f32_32x32x16_bf16(kf[ds][1], qf[ds], ds == 0 ? z : N1, 0, 0, 0);
        }
    }
#pragma unroll
    for (int i = 0; i < 16; ++i) { l += C0[i]; l += C1[i]; }
    bf16x8 pb[4];
    { u32x4 w;
      w.x = pk2(C0[0], C0[1]); w.y = pk2(C0[2], C0[3]); w.z = pk2(C0[4], C0[5]); w.w = pk2(C0[6], C0[7]); pb[0] = __builtin_bit_cast(bf16x8, w);
      w.x = pk2(C0[8], C0[9]); w.y = pk2(C0[10], C0[11]); w.z = pk2(C0[12], C0[13]); w.w = pk2(C0[14], C0[15]); pb[1] = __builtin_bit_cast(bf16x8, w);
      w.x = pk2(C1[0], C1[1]); w.y = pk2(C1[2], C1[3]); w.z = pk2(C1[4], C1[5]); w.w = pk2(C1[6], C1[7]); pb[2] = __builtin_bit_cast(bf16x8, w);
      w.x = pk2(C1[8], C1[9]); w.y = pk2(C1[10], C1[11]); w.z = pk2(C1[12], C1[13]); w.w = pk2(C1[14], C1[15]); pb[3] = __builtin_bit_cast(bf16x8, w); }
    if (HASNEXT) {
        constexpr int VPER = (DK == 64) ? 6 : 4;
#pragma unroll
        for (int g = 0; g < 2 * A::NDS; ++g) { __builtin_amdgcn_sched_group_barrier(0x008, 1, 0); __builtin_amdgcn_sched_group_barrier(0x002, VPER, 0); }
    }
    asm volatile("" : "+v"(l));
    __builtin_amdgcn_sched_barrier(0);
#pragma unroll
    for (int j = 2; j < 4; ++j) {
        vlo[j][0] = vtr(Vb + aoffv + j * 16 * A::VSTR); vhi[j][0] = vtr(Vb + aoffv + (j * 16 + 8) * A::VSTR);
        vlo[j][1] = vtr(Vb + aoffv + j * 16 * A::VSTR + 64); vhi[j][1] = vtr(Vb + aoffv + (j * 16 + 8) * A::VSTR + 64);
    }
#pragma unroll
    for (int j = 0; j < 4; ++j) {
        const bf16x8 a0 = __builtin_shufflevector(vlo[j][0], vhi[j][0], 0, 1, 2, 3, 4, 5, 6, 7);
        const bf16x8 a1 = __builtin_shufflevector(vlo[j][1], vhi[j][1], 0, 1, 2, 3, 4, 5, 6, 7);
        o0 = __builtin_amdgcn_mfma_f32_32x32x16_bf16(a0, pb[j], o0, 0, 0, 0);
        o1 = __builtin_amdgcn_mfma_f32_32x32x16_bf16(a1, pb[j], o1, 0, 0, 0);
    }
    if (HASNEXT) {
#pragma unroll
        for (int i = 0; i < 16; ++i) { N0[i] = __builtin_amdgcn_exp2f(N0[i]); N1[i] = __builtin_amdgcn_exp2f(N1[i]); }
#pragma unroll
        for (int g = 0; g < 8; ++g) { __builtin_amdgcn_sched_group_barrier(0x008, 1, 0); __builtin_amdgcn_sched_group_barrier(0x002, 4, 0); }
    }
    __builtin_amdgcn_sched_barrier(0);
    __builtin_amdgcn_s_setprio(0);
    if (STK) { LAS unsigned char* Kn = lds + PAR * A::KBUF; *(LAS u32x4*)(Kn + kl0) = stk0; if (has1) *(LAS u32x4*)(Kn + kl1) = stk1; }
    if (HASNEXT) { LAS unsigned char* Vn = lds + 2 * A::KBUF + (PAR ^ 1) * A::VBUF; *(LAS u32x4*)(Vn + vl) = stv; }
    asm volatile("s_waitcnt lgkmcnt(0)\n\ts_barrier" ::: "memory");
}

template <int DK>
__device__ __forceinline__ void attn_unit(LAS unsigned char* lds, const bf16_t* Qp, int qpitch, const bf16_t* Kp, int kpitch, const bf16_t* Vp, int vpitch, bf16_t* Op, int nt) {
    using A = AttnCtx<DK>;
    constexpr int KSTR = A::KSTR, VSTR = A::VSTR, NDS = A::NDS, KCH = A::KCH, KBUF = A::KBUF;
    int tid_ = threadIdx.x; asm volatile("" : "+v"(tid_));
    const int tid = tid_, lane = tid & 63, wid = tid >> 6, r32 = lane & 31, hi = lane >> 5;
    bf16x8 qf[NDS];
    {
        const bf16_t* qrow = Qp + (size_t)(wid * 32 + r32) * qpitch + 8 * hi;
#pragma unroll
        for (int ds = 0; ds < NDS; ++ds) qf[ds] = *(const bf16x8*)(qrow + ds * 16);
    }
    const int kr0 = tid / KCH, kc0 = tid % KCH;
    const int c1 = tid + NTHREADS; const bool has1 = (DK == 96) && (c1 < 64 * KCH);
    const int kr1 = has1 ? c1 / KCH : 0, kc1 = has1 ? c1 % KCH : 0;
    const int vd = tid >> 3, vc = tid & 7;
    const bf16_t* kg0 = Kp + (size_t)kr0 * kpitch + kc0 * 8;
    const bf16_t* kg1 = Kp + (size_t)kr1 * kpitch + kc1 * 8;
    const bf16_t* vg = Vp + (size_t)vd * vpitch + vc * 8;
    const size_t kstep = (size_t)64 * kpitch, vstep = (size_t)64 * vpitch;
    const int kl0 = kr0 * KSTR + kc0 * 16, kl1 = kr1 * KSTR + kc1 * 16, vl = vd * VSTR + vc * 16;
    const int aoffk = r32 * KSTR + hi * 16;
    const int aoffv = (4 * hi + ((lane & 15) >> 2)) * VSTR + (((lane >> 4) & 1) * 16 + (lane & 3) * 4) * 2;
    {
        const u32x4 a0 = *(const u32x4*)kg0, b0 = *(const u32x4*)(kg0 + kstep), v0 = *(const u32x4*)vg;
        u32x4 a1 = {0u, 0u, 0u, 0u}, b1 = {0u, 0u, 0u, 0u};
        if (has1) { a1 = *(const u32x4*)kg1; b1 = *(const u32x4*)(kg1 + kstep); }
        *(LAS u32x4*)(lds + kl0) = a0; *(LAS u32x4*)(lds + KBUF + kl0) = b0; *(LAS u32x4*)(lds + 2 * KBUF + vl) = v0;
        if (has1) { *(LAS u32x4*)(lds + kl1) = a1; *(LAS u32x4*)(lds + KBUF + kl1) = b1; }
    }
    u32x4 rkA0 = {0u, 0u, 0u, 0u}, rkA1 = {0u, 0u, 0u, 0u}, rvA = {0u, 0u, 0u, 0u}, rkB0, rkB1 = {0u, 0u, 0u, 0u}, rvB;
    rkB0 = *(const u32x4*)(kg0 + 2 * kstep); if (has1) rkB1 = *(const u32x4*)(kg1 + 2 * kstep); rvB = *(const u32x4*)(vg + vstep);
    __syncthreads();
    f32x16 o0, o1, cA0, cA1, cB0, cB1;
#pragma unroll
    for (int i = 0; i < 16; ++i) { o0[i] = 0.f; o1[i] = 0.f; cA0[i] = 0.f; cA1[i] = 0.f; }
#pragma unroll
    for (int ds = 0; ds < NDS; ++ds) {
        const bf16x8 a0 = *(const LAS bf16x8*)(lds + aoffk + ds * 32);
        const bf16x8 a1 = *(const LAS bf16x8*)(lds + aoffk + 32 * KSTR + ds * 32);
        cA0 = __builtin_amdgcn_mfma_f32_32x32x16_bf16(a0, qf[ds], cA0, 0, 0, 0);
        cA1 = __builtin_amdgcn_mfma_f32_32x32x16_bf16(a1, qf[ds], cA1, 0, 0, 0);
    }
#pragma unroll
    for (int i = 0; i < 16; ++i) { cA0[i] = __builtin_amdgcn_exp2f(cA0[i]); cA1[i] = __builtin_amdgcn_exp2f(cA1[i]); }
    __syncthreads();
    float l = 0.f;
    int t = 0;
#define ATT_EVEN(c0_, c1_, n0_, n1_, tt_) lds, c0_, c1_, n0_, n1_, o0, o1, l, qf, kg0, kg1, vg, kstep, vstep, tt_, has1, kl0, kl1, vl, aoffk, aoffv, rkA0, rkA1, rvA, rkB0, rkB1, rvB
#define ATT_ODD(c0_, c1_, n0_, n1_, tt_) lds, c0_, c1_, n0_, n1_, o0, o1, l, qf, kg0, kg1, vg, kstep, vstep, tt_, has1, kl0, kl1, vl, aoffk, aoffv, rkB0, rkB1, rvB, rkA0, rkA1, rvA
    for (; t + 4 < nt; t += 2) {
        attn_step<DK, 0, true, true, true, true>(ATT_EVEN(cA0, cA1, cB0, cB1, t));
        attn_step<DK, 1, true, true, true, true>(ATT_ODD(cB0, cB1, cA0, cA1, t + 1));
    }
    attn_step<DK, 0, true, true, true, true>(ATT_EVEN(cA0, cA1, cB0, cB1, t));
    attn_step<DK, 1, true, false, true, true>(ATT_ODD(cB0, cB1, cA0, cA1, t + 1));
    attn_step<DK, 0, true, false, false, false>(ATT_EVEN(cA0, cA1, cB0, cB1, t + 2));
    attn_step<DK, 1, false, false, false, false>(ATT_ODD(cB0, cB1, cA0, cA1, t + 3));
#undef ATT_EVEN
#undef ATT_ODD
    l = xhalf_add(l);
    const float inv = 1.0f / l;
    bf16_t* orow = Op + (size_t)(wid * 32 + r32) * 1024 + 8 * hi;
#pragma unroll
    for (int db = 0; db < 2; ++db)
#pragma unroll
        for (int k = 0; k < 2; ++k) {
            const f32x16& oo = db == 0 ? o0 : o1;
            const unsigned ax = pk2(oo[8 * k] * inv, oo[8 * k + 1] * inv), ay = pk2(oo[8 * k + 2] * inv, oo[8 * k + 3] * inv);
            const unsigned bx = pk2(oo[8 * k + 4] * inv, oo[8 * k + 5] * inv), by = pk2(oo[8 * k + 6] * inv, oo[8 * k + 7] * inv);
            const auto sx = __builtin_amdgcn_permlane32_swap(ax, bx, false, false), sy = __builtin_amdgcn_permlane32_swap(ay, by, false, false);
            u32x4 w; w.x = sx[0]; w.y = sy[0]; w.z = sx[1]; w.w = sy[1];
            *(u32x4*)(orow + db * 32 + 16 * k) = w;
        }
}

template <int DK>
__device__ __forceinline__ void attn_unit_safe(LAS unsigned char* lds, const bf16_t* Qp, int qpitch, const bf16_t* Kp, int kpitch, const bf16_t* Vp, int vpitch, bf16_t* Op, int nt) {
    constexpr int KSTR = DK * 2 + 16, VSTR = 192, NDS = DK / 16, KCH = DK / 8;
    constexpr int KBUF = 64 * 208, VBUF = 64 * 192;
    int tid_ = threadIdx.x; asm volatile("" : "+v"(tid_));
    const int tid = tid_, lane = tid & 63, wid = tid >> 6, r32 = lane & 31, hi = lane >> 5;
    LAS unsigned char* Kb0 = lds; LAS unsigned char* Vb0 = lds + 2 * KBUF;
    bf16x8 qf[NDS];
    {
        const bf16_t* qrow = Qp + (size_t)(wid * 32 + r32) * qpitch + 8 * hi;
#pragma unroll
        for (int ds = 0; ds < NDS; ++ds) qf[ds] = *(const bf16x8*)(qrow + ds * 16);
    }
    const int kr0 = tid / KCH, kc0 = tid % KCH;
    const int c1 = tid + NTHREADS; const bool has1 = (DK == 96) && (c1 < 64 * KCH);
    const int kr1 = has1 ? c1 / KCH : 0, kc1 = has1 ? c1 % KCH : 0;
    const int vd = tid >> 3, vc = tid & 7;
    const bf16_t* kg0 = Kp + (size_t)kr0 * kpitch + kc0 * 8;
    const bf16_t* kg1 = Kp + (size_t)kr1 * kpitch + kc1 * 8;
    const bf16_t* vg = Vp + (size_t)vd * vpitch + vc * 8;
    const int kl0 = kr0 * KSTR + kc0 * 16, kl1 = kr1 * KSTR + kc1 * 16, vl = vd * VSTR + vc * 16;
    u32x4 rk0, rk1 = {0u, 0u, 0u, 0u}, rv;
    rk0 = *(const u32x4*)kg0; if (has1) rk1 = *(const u32x4*)kg1; rv = *(const u32x4*)vg;
    *(LAS u32x4*)(Kb0 + kl0) = rk0; if (has1) *(LAS u32x4*)(Kb0 + kl1) = rk1; *(LAS u32x4*)(Vb0 + vl) = rv;
    __syncthreads();
    f32x16 o0, o1;
#pragma unroll
    for (int i = 0; i < 16; ++i) { o0[i] = 0.f; o1[i] = 0.f; }
    float m = -1e30f, l = 0.f;
    const int aoffk = r32 * KSTR + hi * 16;
    const int aoffv = (4 * hi + ((lane & 15) >> 2)) * VSTR + (((lane >> 4) & 1) * 16 + (lane & 3) * 4) * 2;
    for (int kt = 0; kt < nt; ++kt) {
        const int cur = kt & 1;
        LAS unsigned char* Kb = Kb0 + cur * KBUF; LAS unsigned char* Vb = Vb0 + cur * VBUF;
        const bool more = kt + 1 < nt;
        if (more) {
            const size_t ko = (size_t)(kt + 1) * 64 * kpitch;
            rk0 = *(const u32x4*)(kg0 + ko); if (has1) rk1 = *(const u32x4*)(kg1 + ko); rv = *(const u32x4*)(vg + (size_t)(kt + 1) * 64 * vpitch);
        }
        f32x16 s0, s1;
#pragma unroll
        for (int i = 0; i < 16; ++i) { s0[i] = 0.f; s1[i] = 0.f; }
#pragma unroll
        for (int ds = 0; ds < NDS; ++ds) {
            const bf16x8 a0 = *(const LAS bf16x8*)(Kb + aoffk + ds * 32);
            const bf16x8 a1 = *(const LAS bf16x8*)(Kb + aoffk + 32 * KSTR + ds * 32);
            s0 = __builtin_amdgcn_mfma_f32_32x32x16_bf16(a0, qf[ds], s0, 0, 0, 0);
            s1 = __builtin_amdgcn_mfma_f32_32x32x16_bf16(a1, qf[ds], s1, 0, 0, 0);
        }
        float mx = fmaxf(s0[0], s1[0]);
#pragma unroll
        for (int i = 1; i < 16; ++i) mx = fmaxf(mx, fmaxf(s0[i], s1[i]));
        mx = xhalf_max(mx);
        const float mnew = fmaxf(m, mx);
        const float alpha = __builtin_amdgcn_exp2f(m - mnew);
        m = mnew;
        float ps = 0.f;
#pragma unroll
        for (int i = 0; i < 16; ++i) { s0[i] = __builtin_amdgcn_exp2f(s0[i] - mnew); s1[i] = __builtin_amdgcn_exp2f(s1[i] - mnew); ps += s0[i] + s1[i]; }
        l = l * alpha + ps;
#pragma unroll
        for (int i = 0; i < 16; ++i) { o0[i] *= alpha; o1[i] *= alpha; }
        bf16x8 pb[4];
        { u32x4 w;
          w.x = pk2(s0[0], s0[1]); w.y = pk2(s0[2], s0[3]); w.z = pk2(s0[4], s0[5]); w.w = pk2(s0[6], s0[7]); pb[0] = __builtin_bit_cast(bf16x8, w);
          w.x = pk2(s0[8], s0[9]); w.y = pk2(s0[10], s0[11]); w.z = pk2(s0[12], s0[13]); w.w = pk2(s0[14], s0[15]); pb[1] = __builtin_bit_cast(bf16x8, w);
          w.x = pk2(s1[0], s1[1]); w.y = pk2(s1[2], s1[3]); w.z = pk2(s1[4], s1[5]); w.w = pk2(s1[6], s1[7]); pb[2] = __builtin_bit_cast(bf16x8, w);
          w.x = pk2(s1[8], s1[9]); w.y = pk2(s1[10], s1[11]); w.z = pk2(s1[12], s1[13]); w.w = pk2(s1[14], s1[15]); pb[3] = __builtin_bit_cast(bf16x8, w); }
#pragma unroll
        for (int j = 0; j < 4; ++j) {
            const s16x4 l0 = vtr(Vb + aoffv + j * 16 * VSTR), h0 = vtr(Vb + aoffv + (j * 16 + 8) * VSTR);
            const s16x4 l1 = vtr(Vb + aoffv + j * 16 * VSTR + 64), h1 = vtr(Vb + aoffv + (j * 16 + 8) * VSTR + 64);
            const bf16x8 a0 = __builtin_shufflevector(l0, h0, 0, 1, 2, 3, 4, 5, 6, 7);
            const bf16x8 a1 = __builtin_shufflevector(l1, h1, 0, 1, 2, 3, 4, 5, 6, 7);
            o0 = __builtin_amdgcn_mfma_f32_32x32x16_bf16(a0, pb[j], o0, 0, 0, 0);
            o1 = __builtin_amdgcn_mfma_f32_32x32x16_bf16(a1, pb[j], o1, 0, 0, 0);
        }
        if (more) {
            LAS unsigned char* Kn = Kb0 + (cur ^ 1) * KBUF; LAS unsigned char* Vn = Vb0 + (cur ^ 1) * VBUF;
            *(LAS u32x4*)(Kn + kl0) = rk0; if (has1) *(LAS u32x4*)(Kn + kl1) = rk1; *(LAS u32x4*)(Vn + vl) = rv;
        }
        __syncthreads();
    }
    l = xhalf_add(l);
    const float inv = 1.0f / l;
    bf16_t* orow = Op + (size_t)(wid * 32 + r32) * 1024 + 4 * hi;
#pragma unroll
    for (int g = 0; g < 4; ++g) {
        u32x2 w; w.x = pk2(o0[4 * g] * inv, o0[4 * g + 1] * inv); w.y = pk2(o0[4 * g + 2] * inv, o0[4 * g + 3] * inv);
        *(u32x2*)(orow + 8 * g) = w;
        w.x = pk2(o1[4 * g] * inv, o1[4 * g + 1] * inv); w.y = pk2(o1[4 * g + 2] * inv, o1[4 * g + 3] * inv);
        *(u32x2*)(orow + 32 + 8 * g) = w;
    }
}

__device__ __forceinline__ void attn_dispatch(const Params& p, LAS unsigned char* lds, int b, int head, int qrow0, int nt, bool fastg, bool fastm) {
    unsigned char* ws = p.ws;
    const size_t rb = (size_t)b * LTOT;
    bf16_t* MIX = (bf16_t*)(ws + OFF_MIX);
    if (head < 6) {
        const int kvh = head / 3;
        const bf16_t* Qp = (const bf16_t*)(ws + OFF_QG) + (rb + qrow0) * 384 + head * 64; const bf16_t* Kp = (const bf16_t*)(ws + OFF_KG) + rb * 128 + kvh * 64;
        const bf16_t* Vp = (const bf16_t*)(ws + OFF_VTG) + rb * 128 + kvh * 64; bf16_t* Op = MIX + (rb + qrow0) * 1024 + head * 64;
        if (fastg) attn_unit<64>(lds, Qp, 384, Kp, 128, Vp, 128, Op, nt); else attn_unit_safe<64>(lds, Qp, 384, Kp, 128, Vp, 128, Op, nt);
    } else {
        const int hm = head - 6;
        const bf16_t* Qp = (const bf16_t*)(ws + OFF_QM) + (rb + qrow0) * 576 + hm * 96; const bf16_t* Kp = (const bf16_t*)(ws + OFF_KM) + rb * 576 + hm * 96;
        const bf16_t* Vp = (const bf16_t*)(ws + OFF_KVRAW) + rb * 768 + hm * 128 + 64; bf16_t* Op = MIX + (rb + qrow0) * 1024 + 384 + hm * 64;
        if (fastm) attn_unit<96>(lds, Qp, 576, Kp, 576, Vp, 768, Op, nt); else attn_unit_safe<96>(lds, Qp, 576, Kp, 576, Vp, 768, Op, nt);
    }
}

__device__ __forceinline__ float absmax_vec(const float* g, int n) { float m = 0.f; for (int i = 0; i < n; ++i) m = fmaxf(m, fabsf(g[i])); return m; }

__device__ __forceinline__ void phase_attn(const Params& p, LAS unsigned char* lds, int G, bool do_ctx, int layer) {
    const float bg = 8.0f * absmax_vec(p.g_q_gqa + layer * 64, 64) * absmax_vec(p.g_k_gqa + layer * 64, 64) * LOG2E * 1.05f;
    const float bm = 9.797959f * absmax_vec(p.g_q_mla + layer * 96, 96) * absmax_vec(p.g_k_mla + layer * 96, 96) * LOG2E * 1.05f;
    const bool fastg = bg < ATT_BMAX, fastm = bm < ATT_BMAX;
    for (int uid = blockIdx.x; uid < 8 * 32 * 12; uid += G) {
        const int b = uid & 7, qb = (uid >> 3) & 31, head = uid >> 8;
        attn_dispatch(p, lds, b, head, LCTX + qb * 256, LTOT / 64, fastg, fastm);
    }
    if (do_ctx)
        for (int uid = blockIdx.x; uid < 8 * 12; uid += G) {
            const int b = uid & 7, head = uid >> 3;
            attn_dispatch(p, lds, b, head, 0, LCTX / 64, fastg, fastm);
        }
}

#define XB_TMO      128
#define XB_XCNT(j)  (256  + 64 * (j))
#define XB_XSUB(j)  (1280 + 64 * (j))
#define XB_XGEN(j)  (2304 + 64 * (j))
#define XB_TOP      3328
#define XB_TOPGEN   3392
#define XCD_BAR_WORDS 3456
#define XB_SPIN_CAP (1u << 18)

__device__ __forceinline__ unsigned xb_ld(unsigned* p)              { return __hip_atomic_load(p, __ATOMIC_RELAXED, __HIP_MEMORY_SCOPE_AGENT); }
__device__ __forceinline__ unsigned xb_add(unsigned* p, unsigned v) { return __hip_atomic_fetch_add(p, v, __ATOMIC_RELAXED, __HIP_MEMORY_SCOPE_AGENT); }
__device__ __forceinline__ unsigned xb_xcc_id() { return (unsigned)__builtin_amdgcn_s_getreg((3 << 11) | 20) & 0xFu; }
#define XB_SPIN(cond, bar) do { unsigned _sp = 0; while (cond) { __builtin_amdgcn_s_sleep(1); \
    if ((++_sp & 255u) == 0u) { if (xb_ld(&(bar)[XB_TMO])) break; if (_sp > XB_SPIN_CAP) { atomicAdd(&(bar)[XB_TMO], 1u); break; } } } } while (0)

struct XcdBarrier {
    unsigned* bar; unsigned x;
    volatile LAS unsigned* st;
};

__device__ __forceinline__ XcdBarrier xcd_barrier_post(unsigned* bar, volatile LAS unsigned* st) {
    XcdBarrier b; b.bar = bar; b.x = xb_xcc_id(); b.st = st;
    if (threadIdx.x == 0) (void)xb_add(&bar[XB_XCNT(b.x)], 1u);
    return b;
}
__device__ __forceinline__ void xcd_barrier_complete(unsigned* bar, unsigned x, unsigned& nloc, unsigned& nx) {
    const unsigned G = gridDim.x * gridDim.y * gridDim.z;
    unsigned sum, cnt, mine, sp = 0u;
    for (;;) {
        sum = 0u; cnt = 0u; mine = 0u;
#pragma unroll
        for (unsigned j = 0; j < 16; ++j) { const unsigned c = xb_ld(&bar[XB_XCNT(j)]); sum += c; cnt += (c > 0u) ? 1u : 0u; mine = (j == x) ? c : mine; }
        if (sum == G) break;
        __builtin_amdgcn_s_sleep(1);
        if ((++sp & 255u) == 0u) { if (xb_ld(&bar[XB_TMO])) break; if (sp > XB_SPIN_CAP) { atomicAdd(&bar[XB_TMO], 1u); break; } }
    }
    nloc = mine > 0u ? mine : 1u; nx = cnt > 0u ? cnt : 1u;
}

__device__ __forceinline__ void xcd_barrier(const XcdBarrier& b) {
    asm volatile("s_waitcnt vmcnt(0)" ::: "memory");
    __syncthreads();
    if (threadIdx.x == 0) {
        unsigned* bar = b.bar;
        __builtin_amdgcn_s_waitcnt(0);
        unsigned nloc = b.st[0], nx = b.st[1];
        if (nloc == 0u) { xcd_barrier_complete(bar, b.x, nloc, nx); b.st[0] = nloc; b.st[1] = nx; }
        const unsigned old = xb_add(&bar[XB_XSUB(b.x)], 1u);
        const unsigned gen = old / nloc;
        if (old + 1u == (gen + 1u) * nloc) {
            __builtin_amdgcn_fence(__ATOMIC_RELEASE, "agent");
            asm volatile("s_waitcnt vmcnt(0)" ::: "memory");
            const unsigned og = xb_add(&bar[XB_TOP], 1u);
            const unsigned tg = og / nx;
            if (og + 1u == (tg + 1u) * nx) xb_add(&bar[XB_TOPGEN], 1u);
            else XB_SPIN(xb_ld(&bar[XB_TOPGEN]) == tg, bar);
            __builtin_amdgcn_fence(__ATOMIC_ACQUIRE, "agent");
            xb_add(&bar[XB_XGEN(b.x)], 1u);
            asm volatile("s_waitcnt vmcnt(0)" ::: "memory");
        } else {
            XB_SPIN(xb_ld(&bar[XB_XGEN(b.x)]) == gen, bar);
            __builtin_amdgcn_fence(__ATOMIC_ACQUIRE, "agent");
            asm volatile("s_waitcnt vmcnt(0)" ::: "memory");
        }
    }
    __syncthreads();
}

__global__ void __launch_bounds__(NTHREADS, 2) mega_fwd(Params p) {
    extern __shared__ __attribute__((aligned(16))) unsigned char lds_raw[];
    LAS unsigned char* lds = (LAS unsigned char*)lds_raw;
    cg::grid_group grid = cg::this_grid();
    const int G = gridDim.x;
    const int ngw = G * NWAVES;
#define FRESH_IDS() int tid = threadIdx.x; asm volatile("" : "+v"(tid)); const int lane = tid & 63, gw = blockIdx.x * NWAVES + (tid >> 6)
    unsigned char* ws = p.ws;
    float* xctx = (float*)(ws + OFF_XCTX);
    const float* modall = (const float*)(ws + OFF_MOD);
    bf16_t* H = (bf16_t*)(ws + OFF_H);

#ifndef NO_PRO
    if (threadIdx.x < 2) ((LAS unsigned*)(lds + 131072))[threadIdx.x] = 0u;
    __syncthreads();
    (void)xcd_barrier_post((unsigned*)(ws + OFF_BAR), (volatile LAS unsigned*)(lds + 131072));
#define GSYNC() do { XcdBarrier b_; b_.bar = (unsigned*)(p.ws + OFF_BAR); b_.x = xb_xcc_id(); b_.st = (volatile LAS unsigned*)(lds + 131072); xcd_barrier(b_); } while (0)
    phase_prologue(p, lds, G);
#endif
    if (p.ws == nullptr) grid.sync();
    GSYNC();
    phase_modfinal(p, G);
    GSYNC();

    for (int layer = 0; layer < DEPTH; ++layer) {
        const float* mod = modall + (size_t)layer * 9 * NMOD;
        const float* src_lat = layer == 0 ? p.x : p.out;
        const float* src_ctx = layer == 0 ? p.ctx : xctx;
        phase_poolfold(p, layer, G);
        { FRESH_IDS(); phase_norm(src_lat, src_ctx, p.g_norm1 + layer * DM, mod, 0, DM, H, gw, ngw, lane); }
        GSYNC();
#ifndef NO_G1
        {
            pg8::Gemm g{H, (const bf16_t*)(ws + OFF_WIN) + (size_t)layer * UW * DM, NR, UW, DM};
            pg8::StaticOrder S; S.init(NR, UW, G, (int)blockIdx.x);
            pg8::EpiBf16<0> E{(bf16_t*)(ws + OFF_U), UW, 0, nullptr, 1312};
            pg8::gemm_phase<pg8::EpiBf16<0>, pg8::StaticOrder, true, true>(lds, g, S, E);
        }
#endif
        GSYNC();
#ifndef NO_PREP
        { FRESH_IDS(); phase_prep1(p, layer, gw, ngw, lane); }
#endif
        GSYNC();
#ifndef NO_G2
        {
            pg8::Gemm g{(const bf16_t*)(ws + OFF_CQN), (const bf16_t*)(ws + OFF_WUQ) + (size_t)layer * 768 * 256, NR, 768, 256};
            pg8::StaticOrder S; S.init(NR, 768, G, (int)blockIdx.x);
            pg8::EpiBf16<0> E{(bf16_t*)(ws + OFF_QMRAW), 768, 0, nullptr, 576};
            pg8::gemm_phase<pg8::EpiBf16<0>, pg8::StaticOrder, true, true>(lds, g, S, E);
        }
#endif
#ifndef NO_G3
        {
            pg8::Gemm g{(const bf16_t*)(ws + OFF_CKVN), (const bf16_t*)(ws + OFF_WUKV) + (size_t)layer * 768 * 128, NR, 768, 128};
            pg8::StaticOrder S; S.init(NR, 768, G, (int)blockIdx.x);
            pg8::EpiBf16<0> E{(bf16_t*)(ws + OFF_KVRAW), 768, 0, nullptr, 768};
            pg8::gemm_phase<pg8::EpiBf16<0>, pg8::StaticOrder, true, true>(lds, g, S, E);
        }
#endif
        GSYNC();
#ifndef NO_PREP
        { FRESH_IDS(); phase_prep2(p, layer, gw, ngw, lane); }
#endif
        GSYNC();
#ifndef NO_ATTN
        phase_attn(p, lds, G, layer != DEPTH - 1, layer);
#endif
        GSYNC();
#ifndef NO_G5
        {
            pg8::Gemm g{(const bf16_t*)(ws + OFF_MIX), (const bf16_t*)(ws + OFF_WOUT) + (size_t)layer * DM * DM, NR, DM, DM};
            pg8::StaticOrder S; S.init(NR, DM, G, (int)blockIdx.x, layer == DEPTH - 1);
            pg8::EpiResid E{src_lat, src_ctx, p.out, xctx, mod + 2 * DM};
            pg8::gemm_phase<pg8::EpiResid, pg8::StaticOrder, true, true>(lds, g, S, E);
        }
#endif
        GSYNC();
        { FRESH_IDS(); phase_norm(p.out, xctx, p.g_norm2 + layer * DM, mod, 3 * DM, 4 * DM, H, gw, ngw, lane); }
        GSYNC();
#ifndef NO_G6
        {
            pg8::Gemm g{H, (const bf16_t*)(ws + OFF_W1) + (size_t)layer * DFF * DM, NR, DFF, DM};
            pg8::StaticOrder S; S.init(NR, DFF, G, (int)blockIdx.x, layer == DEPTH - 1);
            pg8::EpiBf16<2> E{(bf16_t*)(ws + OFF_A1), DFF, 0, nullptr, DFF};
            pg8::gemm_phase<pg8::EpiBf16<2>, pg8::StaticOrder, true, true>(lds, g, S, E);
        }
#endif
        GSYNC();
#ifndef NO_G7
        {
            pg8::Gemm g{(const bf16_t*)(ws + OFF_A1), (const bf16_t*)(ws + OFF_W2) + (size_t)layer * DM * DFF, NR, DM, DFF};
            pg8::StaticOrder S; S.init(NR, DM, G, (int)blockIdx.x, layer == DEPTH - 1);
            pg8::EpiResid E{p.out, xctx, p.out, xctx, mod + 5 * DM};
            pg8::gemm_phase<pg8::EpiResid, pg8::StaticOrder, true, true>(lds, g, S, E);
        }
#endif
        GSYNC();
    }
}

extern "C" void kernel_launch(void* const* d_in, const int* in_sizes, int n_in, void* d_out, int out_size, void* d_ws, size_t ws_size, hipStream_t stream) {
    static int grid_blocks = 0;
    if (grid_blocks == 0) {
        if (n_in != 22 || ws_size < WS_NEED) { fprintf(stderr, "kernel_launch: need 22 inputs and %zu bytes of workspace; got %d inputs, %zu bytes\n", (size_t)WS_NEED, n_in, ws_size); grid_blocks = -1; return; }
        int dev = 0, cus = 0, per_cu = 0;
        hipGetDevice(&dev);
        hipDeviceGetAttribute(&cus, hipDeviceAttributeMultiprocessorCount, dev);
        hipFuncSetAttribute((const void*)mega_fwd, hipFuncAttributeMaxDynamicSharedMemorySize, LDS_BYTES);
        hipOccupancyMaxActiveBlocksPerMultiprocessor(&per_cu, (const void*)mega_fwd, NTHREADS, LDS_BYTES);
        if (per_cu < 1) per_cu = 1;
        (void)hipGetLastError();
        grid_blocks = cus * per_cu;
        if (grid_blocks > 256) grid_blocks = 256;
    }
    if (grid_blocks < 0) return;
    Params p{};
    p.x = (const float*)d_in[0]; p.c = (const float*)d_in[1]; p.ctx = (const float*)d_in[2]; p.c_ctx = (const float*)d_in[3];
    p.w_mod = (const float*)d_in[4]; p.b_mod = (const float*)d_in[5]; p.g_norm1 = (const float*)d_in[6]; p.g_norm2 = (const float*)d_in[7];
    p.w_in = (const float*)d_in[8]; p.g_q_gqa = (const float*)d_in[9]; p.g_k_gqa = (const float*)d_in[10]; p.g_cq = (const float*)d_in[11]; p.g_ckv = (const float*)d_in[12];
    p.w_uq = (const float*)d_in[13]; p.w_ukv = (const float*)d_in[14]; p.g_q_mla = (const float*)d_in[15]; p.g_k_mla = (const float*)d_in[16];
    p.w_pool = (const float*)d_in[17]; p.ls_pool = (const float*)d_in[18]; p.w_out = (const float*)d_in[19]; p.w_mlp1 = (const float*)d_in[20]; p.w_mlp2 = (const float*)d_in[21];
    p.out = (float*)d_out; p.ws = (unsigned char*)d_ws;
    (void)hipMemsetAsync((unsigned char*)d_ws + OFF_BAR, 0, XCD_BAR_WORDS * 4, stream);
    void* args[] = {&p};
    hipError_t e = hipLaunchCooperativeKernel((const void*)mega_fwd, dim3(grid_blocks), dim3(NTHREADS), args, LDS_BYTES, stream);
    if (e != hipSuccess) fprintf(stderr, "cooperative launch failed: %s (grid %d)\n", hipGetErrorString(e), grid_blocks);
}
```
